# Optimizing an MI355X kernel written in HIP

```python
import math
import jax, jax.numpy as jnp
from jax import lax
import numpy as np

D_MODEL = 1024
BATCH = 4
SEQ = 4096
DEPTH = 1

D_MIX = D_MODEL
D_RNN = D_MIX // 2
RNN_BLOCKS = 8
RNN_BW = D_RNN // RNN_BLOCKS
CONV_W = 4
RG_C = 8.0
D_ATT = D_MIX - D_RNN
HEAD_DIM = 64
N_HEADS = D_ATT // HEAD_DIM
Q_BLOCK = 128
D_FF = 2816
N_IN = 2 * D_RNN + 3 * D_ATT
EPS = 1e-6

kernel_name = "hybrid_rglru_stickbreaking_macaron"


def _rms_norm(x, g):
    xf = x.astype(jnp.float32)
    r = lax.rsqrt(jnp.mean(xf * xf, axis=-1, keepdims=True) + EPS)
    return (xf * r * g.astype(jnp.float32)).astype(x.dtype)


def _swiglu(x, w_gate, w_up, w_down):
    return (jax.nn.silu(x @ w_gate) * (x @ w_up)) @ w_down


def _lin_combine(left, right):
    a1, b1 = left
    a2, b2 = right
    return a1 * a2, a2 * b1 + b2


def _rg_lru_group(xr, gate, conv_w, conv_b, w_a, b_a, w_x, b_x, lam):
    bsz, seq, _ = xr.shape
    kern = conv_w.astype(xr.dtype)[:, None, :]
    xc = lax.conv_general_dilated(
        xr, kern, window_strides=(1,), padding=[(CONV_W - 1, 0)],
        dimension_numbers=("NWC", "WIO", "NWC"), feature_group_count=D_RNN,
    ) + conv_b
    xb = xc.reshape(bsz, seq, RNN_BLOCKS, RNN_BW)
    r = jax.nn.sigmoid(jnp.einsum("bsnc,ncd->bsnd", xb, w_a).reshape(bsz, seq, D_RNN) + b_a)
    i = jax.nn.sigmoid(jnp.einsum("bsnc,ncd->bsnd", xb, w_x).reshape(bsz, seq, D_RNN) + b_x)
    log_a = RG_C * r.astype(jnp.float32) * jax.nn.log_sigmoid(lam.astype(jnp.float32))
    a = jnp.exp(log_a)
    mult = jnp.sqrt(-jnp.expm1(2.0 * log_a))
    b = mult * (i * xc).astype(jnp.float32)
    _, h = lax.associative_scan(_lin_combine, (a, b), axis=1)
    return h.astype(xr.dtype) * jax.nn.gelu(gate)


def _stick_breaking(q, k, v):
    seq = q.shape[2]
    k_pos = jnp.arange(seq)
    kf = k.astype(jnp.float32)
    vf = v.astype(jnp.float32)

    def block(i):
        start = i * Q_BLOCK
        qb = lax.dynamic_slice_in_dim(q, start, Q_BLOCK, axis=2).astype(jnp.float32)
        z = jnp.einsum("bhqd,bhkd->bhqk", qb, kf)
        q_pos = start + jnp.arange(Q_BLOCK)
        causal = k_pos[None, :] < q_pos[:, None]
        log_beta = jax.nn.log_sigmoid(z)
        log_1m = jnp.where(causal, jax.nn.log_sigmoid(-z), 0.0)
        tail = lax.cumsum(log_1m, axis=log_1m.ndim - 1, reverse=True) - log_1m
        w = jnp.where(causal, jnp.exp(log_beta + tail), 0.0)
        return jnp.einsum("bhqk,bhkd->bhqd", w, vf)

    out = lax.map(block, jnp.arange(seq // Q_BLOCK))
    nb, bsz, nh, qb, dh = out.shape
    out = jnp.transpose(out, (1, 0, 3, 2, 4)).reshape(bsz, seq, nh * dh)
    return out.astype(q.dtype)


def setup_inputs(seed: int = 0) -> dict:
    key = jax.random.key(seed)
    ks = jax.random.split(key, 24)
    f32 = jnp.float32

    def nrm(k, shape, scale):
        return jax.random.normal(k, shape, f32) * scale

    def gain(k, n):
        return 1.0 + 0.02 * jax.random.normal(k, (DEPTH, n), f32)

    a_base = jax.random.uniform(ks[13], (DEPTH, D_RNN), f32, 0.9, 0.999)
    s = a_base ** (1.0 / RG_C)
    rg_lambda = jnp.log(s) - jnp.log1p(-s)
    return {
        "x": nrm(ks[0], (BATCH, SEQ, D_MODEL), 1.0),
        "ffn1_norm": gain(ks[1], D_MODEL),
        "ffn1_w_gate": nrm(ks[2], (DEPTH, D_MODEL, D_FF), D_MODEL ** -0.5),
        "ffn1_w_up": nrm(ks[3], (DEPTH, D_MODEL, D_FF), D_MODEL ** -0.5),
        "ffn1_w_down": nrm(ks[4], (DEPTH, D_FF, D_MODEL), D_FF ** -0.5),
        "mix_norm": gain(ks[5], D_MODEL),
        "w_in": nrm(ks[6], (DEPTH, D_MODEL, N_IN), D_MODEL ** -0.5),
        "conv_w": nrm(ks[7], (DEPTH, CONV_W, D_RNN), CONV_W ** -0.5),
        "conv_b": nrm(ks[8], (DEPTH, D_RNN), 0.01),
        "rg_w_a": nrm(ks[9], (DEPTH, RNN_BLOCKS, RNN_BW, RNN_BW), RNN_BW ** -0.5),
        "rg_b_a": nrm(ks[10], (DEPTH, D_RNN), 0.01),
        "rg_w_x": nrm(ks[11], (DEPTH, RNN_BLOCKS, RNN_BW, RNN_BW), RNN_BW ** -0.5),
        "rg_b_x": nrm(ks[12], (DEPTH, D_RNN), 0.01),
        "rg_lambda": rg_lambda,
        "q_norm": gain(ks[14], HEAD_DIM),
        "k_norm": gain(ks[15], HEAD_DIM),
        "rnn_out_norm": gain(ks[16], D_RNN),
        "attn_out_norm": gain(ks[17], D_ATT),
        "w_out": nrm(ks[18], (DEPTH, D_MIX, D_MODEL), D_MIX ** -0.5),
        "ffn2_norm": gain(ks[19], D_MODEL),
        "ffn2_w_gate": nrm(ks[20], (DEPTH, D_MODEL, D_FF), D_MODEL ** -0.5),
        "ffn2_w_up": nrm(ks[21], (DEPTH, D_MODEL, D_FF), D_MODEL ** -0.5),
        "ffn2_w_down": nrm(ks[22], (DEPTH, D_FF, D_MODEL), D_FF ** -0.5),
    }


def reference(x, ffn1_norm, ffn1_w_gate, ffn1_w_up, ffn1_w_down, mix_norm, w_in,
              conv_w, conv_b, rg_w_a, rg_b_a, rg_w_x, rg_b_x, rg_lambda,
              q_norm, k_norm, rnn_out_norm, attn_out_norm, w_out,
              ffn2_norm, ffn2_w_gate, ffn2_w_up, ffn2_w_down):
    bsz, seq, _ = x.shape
    scale = 1.0 / math.sqrt(HEAD_DIM)
    for l in range(DEPTH):
        x = x + 0.5 * _swiglu(_rms_norm(x, ffn1_norm[l]), ffn1_w_gate[l], ffn1_w_up[l], ffn1_w_down[l])

        h = _rms_norm(x, mix_norm[l])
        proj = h @ w_in[l]
        xr, gate, q, k, v = jnp.split(
            proj, [D_RNN, 2 * D_RNN, 2 * D_RNN + D_ATT, 2 * D_RNN + 2 * D_ATT], axis=-1)

        y_rnn = _rg_lru_group(xr, gate, conv_w[l], conv_b[l], rg_w_a[l], rg_b_a[l],
                              rg_w_x[l], rg_b_x[l], rg_lambda[l])

        def heads(t):
            return jnp.transpose(t.reshape(bsz, seq, N_HEADS, HEAD_DIM), (0, 2, 1, 3))
        qh = _rms_norm(heads(q), q_norm[l]) * scale
        kh = _rms_norm(heads(k), k_norm[l])
        y_att = _stick_breaking(qh, kh, heads(v))

        y = jnp.concatenate([_rms_norm(y_rnn, rnn_out_norm[l]),
                             _rms_norm(y_att, attn_out_norm[l])], axis=-1)
        x = x + y @ w_out[l]

        x = x + 0.5 * _swiglu(_rms_norm(x, ffn2_norm[l]), ffn2_w_gate[l], ffn2_w_up[l], ffn2_w_down[l])
    return x
```

```cpp
#include <hip/hip_runtime.h>
#include <cstdio>
#include <cstdint>
namespace pg8 {
#define PG8_LAS __attribute__((address_space(3)))
typedef unsigned short bf16_t;
typedef short bf16x8 __attribute__((ext_vector_type(8)));
typedef float f32x4 __attribute__((ext_vector_type(4)));
typedef unsigned u32x4 __attribute__((ext_vector_type(4)));
constexpr int BM = 256, BK = 64, HALF = 128, HTB = HALF * BK * 2  , STAGE_BYTES = 8 * HTB, NXCD = 8, WGM = 8;

__host__ __device__ __forceinline__ int lds_byte(int r, int c) { const int st = (r >> 4) * 2 + (c >> 5), rr = r & 15, cc = c & 31, ob = rr * 64 + cc * 2; return st * 1024 + (ob ^ (((ob >> 9) & 1) << 5)); }
__host__ __device__ __forceinline__ void stage_rc(int b, int& R, int& C) { const int st = b / 1024, sb = b % 1024, swz = sb ^ (((sb >> 9) & 1) << 5); R = (st >> 1) * 16 + swz / 64; C = (st & 1) * 32 + (swz % 64) / 2; }
__host__ __device__ __forceinline__ int perm32(int rho) { const int n = rho >> 4, i = rho & 15; return 8 * (i >> 2) + 4 * n + (i & 3); }

struct Unit { int pm, pn; };
struct Gemm { const bf16_t* A; const bf16_t* Bt; int M, N, K; };

struct StaticOrder {
    int nM, nN, nwg, G, c;
    __host__ __device__ void init(int M, int N, int G_, int c_) { nM = M / BM; nN = N / BM; nwg = nM * nN; G = G_; c = c_; }
    __host__ __device__ bool next(int i, Unit& u) const {
        const long L = (long)i * G + c; if (L >= nwg) return false;
        int wgid = (int)L; { const int q = nwg / NXCD, r = nwg % NXCD, xcd = wgid % NXCD, off = wgid / NXCD; wgid = (xcd < r ? xcd * (q + 1) : r * (q + 1) + (xcd - r) * q) + off; }
        const int nig = WGM * nN, gid = wgid / nig, fm = gid * WGM, gsz = (nM - fm) < WGM ? (nM - fm) : WGM;
        u.pm = fm + ((wgid % nig) % gsz); u.pn = (wgid % nig) / gsz; return true;
    }
    __device__ __forceinline__ void a_ready(const Unit&) const {}
    __device__ __forceinline__ void done(const Unit&) const {}
};

__device__ __forceinline__ unsigned cvt_pk_bf16(float lo, float hi) { unsigned r; asm volatile("v_cvt_pk_bf16_f32 %0, %1, %2" : "=v"(r) : "v"(lo), "v"(hi)); return r; }
typedef float f32x2 __attribute__((ext_vector_type(2)));

__device__ __forceinline__ float row_rs(const float* ssq, int row, float inv_n, float eps) {
    const f32x4* p = (const f32x4*)(ssq + (size_t)row * 16);
    const f32x4 a = p[0], b = p[1], c = p[2], d = p[3];
    const float s = (((a[0] + a[1]) + (a[2] + a[3])) + ((b[0] + b[1]) + (b[2] + b[3]))) + (((c[0] + c[1]) + (c[2] + c[3])) + ((d[0] + d[1]) + (d[2] + d[3])));
    return __builtin_amdgcn_rsqf(s * inv_n + eps);
}
__device__ __forceinline__ float silu_mul(float g, float up) { return g * __builtin_amdgcn_rcpf(1.0f + __builtin_amdgcn_exp2f(-1.4426950408889634f * g)) * up; }

struct EpiSwiGLU {
    static constexpr bool PERM = true, AFTER_DRAIN = false;
    bf16_t* O; int ldc; const float* ssq;
    __device__ __forceinline__ void operator()(const f32x4 (&acc)[2][2][4][2], const Unit& u, int wr, int wc, int fr, int fq) const {
        const int row0 = u.pm * BM + wr * 64 + fr, col0 = u.pn * HALF + wc * 32 + 8 * fq;
#pragma unroll
        for (int ai = 0; ai < 2; ++ai)
#pragma unroll
            for (int m = 0; m < 4; ++m) {
                const int row = row0 + ai * HALF + m * 16;
                const float rs = row_rs(ssq, row, 1.0f / 1024.0f, 1e-6f);
                float o[8];
#pragma unroll
                for (int n = 0; n < 2; ++n)
#pragma unroll
                    for (int e = 0; e < 4; ++e) o[n * 4 + e] = silu_mul(acc[ai][0][m][n][e] * rs, acc[ai][1][m][n][e] * rs);
                u32x4 w; w.x = cvt_pk_bf16(o[0], o[1]); w.y = cvt_pk_bf16(o[2], o[3]); w.z = cvt_pk_bf16(o[4], o[5]); w.w = cvt_pk_bf16(o[6], o[7]);
                *(u32x4*)(O + (size_t)row * ldc + col0) = w;
            }
    }
};

struct EpiResid {
    static constexpr bool PERM = true, AFTER_DRAIN = false;
    const float* resid; float* out; bf16_t* xb; float* ssq_out; float alpha;
    __device__ __forceinline__ void operator()(const f32x4 (&acc)[2][2][4][2], const Unit& u, int wr, int wc, int fr, int fq) const {
        const int row0 = u.pm * BM + wr * 64 + fr, col0 = u.pn * BM + wc * 32 + 8 * fq;
#pragma unroll
        for (int ai = 0; ai < 2; ++ai)
#pragma unroll
            for (int m = 0; m < 4; ++m) {
                const int row = row0 + ai * HALF + m * 16; float s = 0.f;
#pragma unroll
                for (int bj = 0; bj < 2; ++bj) {
                    const size_t off = (size_t)row * 1024 + col0 + bj * HALF;
                    const f32x4 r0 = *(const f32x4*)(resid + off), r1 = *(const f32x4*)(resid + off + 4);
                    const f32x4 v0 = r0 + acc[ai][bj][m][0] * alpha, v1 = r1 + acc[ai][bj][m][1] * alpha;
                    *(f32x4*)(out + off) = v0; *(f32x4*)(out + off + 4) = v1;
                    if (xb) { u32x4 w; w.x = cvt_pk_bf16(v0[0], v0[1]); w.y = cvt_pk_bf16(v0[2], v0[3]); w.z = cvt_pk_bf16(v1[0], v1[1]); w.w = cvt_pk_bf16(v1[2], v1[3]); *(u32x4*)(xb + off) = w; }
                    s += ((v0[0] * v0[0] + v0[1] * v0[1]) + (v0[2] * v0[2] + v0[3] * v0[3])) + ((v1[0] * v1[0] + v1[1] * v1[1]) + (v1[2] * v1[2] + v1[3] * v1[3]));
                }
                if (ssq_out) { s += __shfl_xor(s, 16); s += __shfl_xor(s, 32); if (fq == 0) ssq_out[(size_t)row * 16 + u.pn * 4 + wc] = s; }
            }
    }
};

struct EpiInProj {
    static constexpr bool PERM = true, AFTER_DRAIN = false;
    bf16_t* O; const float* ssq; const float* qn; const float* kn;
    __device__ __forceinline__ void operator()(const f32x4 (&acc)[2][2][4][2], const Unit& u, int wr, int wc, int fr, int fq) const {
        const int row0 = u.pm * BM + wr * 64 + fr, col0 = u.pn * BM + wc * 64 + 8 * fq;
        const bool isq = (u.pn == 4 || u.pn == 5), isk = (u.pn == 6 || u.pn == 7), hn = isq || isk;
        f32x4 gn[2][2];
#pragma unroll
        for (int bj = 0; bj < 2; ++bj)
#pragma unroll
            for (int n = 0; n < 2; ++n) { gn[bj][n] = (f32x4){1.f, 1.f, 1.f, 1.f}; if (hn) gn[bj][n] = *(const f32x4*)((isq ? qn : kn) + 32 * bj + 8 * fq + 4 * n) * (isq ? 0.125f : 1.0f); }
#pragma unroll
        for (int ai = 0; ai < 2; ++ai)
#pragma unroll
            for (int m = 0; m < 4; ++m) {
                const int row = row0 + ai * HALF + m * 16;
                const float rs = row_rs(ssq, row, 1.0f / 1024.0f, 1e-6f);
                f32x4 v[2][2]; float s = 0.f;
#pragma unroll
                for (int bj = 0; bj < 2; ++bj)
#pragma unroll
                    for (int n = 0; n < 2; ++n) { v[bj][n] = acc[ai][bj][m][n] * rs; const f32x4 t = v[bj][n]; s += (t[0] * t[0] + t[1] * t[1]) + (t[2] * t[2] + t[3] * t[3]); }
                if (hn) { s += __shfl_xor(s, 16); s += __shfl_xor(s, 32); const float rq = __builtin_amdgcn_rsqf(s * (1.0f / 64.0f) + 1e-6f);
#pragma unroll
                    for (int bj = 0; bj < 2; ++bj)
#pragma unroll
                        for (int n = 0; n < 2; ++n) v[bj][n] = v[bj][n] * rq * gn[bj][n]; }
#pragma unroll
                for (int bj = 0; bj < 2; ++bj) { u32x4 w; w.x = cvt_pk_bf16(v[bj][0][0], v[bj][0][1]); w.y = cvt_pk_bf16(v[bj][0][2], v[bj][0][3]); w.z = cvt_pk_bf16(v[bj][1][0], v[bj][1][1]); w.w = cvt_pk_bf16(v[bj][1][2], v[bj][1][3]);
                    *(u32x4*)(O + (size_t)row * 2560 + col0 + 32 * bj) = w; }
            }
    }
};

template <class Epi, class Sched, bool ALIGN_EPI = false, bool SP2 = false>
__device__ __forceinline__ void gemm_phase(PG8_LAS unsigned char* lds, const Gemm g, const Sched& S, const Epi& E) {
    const int tid = threadIdx.x, wid = __builtin_amdgcn_readfirstlane(tid >> 6), lane = tid & 63, wr = wid >> 2, wc = wid & 3, fr = lane & 15, fq = lane >> 4;
    const int K = g.K, nt = K / BK;
    unsigned voffA[2], voffB[2];
#pragma unroll
    for (int i = 0; i < 2; ++i) { int R, C; stage_rc(tid * 16 + i * 8192, R, C); const int Rb = Epi::PERM ? ((R & ~31) + perm32(R & 31)) : R;
        voffA[i] = (unsigned)(R * K + C) * 2u; voffB[i] = (unsigned)(Rb * K + C) * 2u; }
    const size_t kstep = (size_t)(BK * 2);
    const size_t hstep = (size_t)HALF * K * 2;
    const size_t tstep = 2 * hstep;
    const unsigned ldsw = (unsigned)wid * 1024u;
    const int aoff = lds_byte(wr * 64 + fr, fq * 8), boff = lds_byte(wc * 32 + fr, fq * 8);
#define PG8_SA(b, h) (((b) * 2 + (h)) * HTB)
#define PG8_SB(b, h) ((4 + (b) * 2 + (h)) * HTB)
#define PG8_STAGE(bufoff, gbase, voff) do { _Pragma("unroll") for (int _i = 0; _i < 2; ++_i) \
        __builtin_amdgcn_global_load_lds((const unsigned*)((const char*)(gbase) + (voff)[_i]), (PG8_LAS unsigned*)(lds + (bufoff) + ldsw + _i * 8192), 16, 0, 0); } while (0)
#define PG8_LDA(dst, b, h) do { _Pragma("unroll") for (int m = 0; m < 4; ++m) _Pragma("unroll") for (int k = 0; k < 2; ++k) dst[m][k] = *(const PG8_LAS bf16x8*)(lds + PG8_SA(b, h) + aoff + m * 2048 + k * 1024); } while (0)
#define PG8_LDB(dst, b, h) do { _Pragma("unroll") for (int n = 0; n < 2; ++n) _Pragma("unroll") for (int k = 0; k < 2; ++k) dst[n][k] = *(const PG8_LAS bf16x8*)(lds + PG8_SB(b, h) + boff + n * 2048 + k * 1024); } while (0)
#define PG8_MMA(ai, bj, At, Bt) do { __builtin_amdgcn_s_setprio(1); _Pragma("unroll") for (int m = 0; m < 4; ++m) _Pragma("unroll") for (int n = 0; n < 2; ++n) _Pragma("unroll") for (int k = 0; k < 2; ++k) \
        acc[ai][bj][m][n] = __builtin_amdgcn_mfma_f32_16x16x32_bf16(Bt[n][k], At[m][k], acc[ai][bj][m][n], 0, 0, 0); __builtin_amdgcn_s_setprio(0); } while (0)
#define PG8_WAIT_V(n) asm volatile("s_waitcnt vmcnt(" #n ")" ::: "memory")
#define PG8_WAIT_L(n) asm volatile("s_waitcnt lgkmcnt(" #n ")" ::: "memory")
#define PG8_BAR __builtin_amdgcn_s_barrier()
#define PG8_SCHED __builtin_amdgcn_sched_barrier(0)
    Unit cur, nxt; int ui = 0;
    if (!S.next(0, cur)) return;
    f32x4 acc[2][2][4][2];
#pragma unroll
    for (int a = 0; a < 2; ++a)
#pragma unroll
        for (int b = 0; b < 2; ++b)
#pragma unroll
            for (int m = 0; m < 4; ++m)
#pragma unroll
                for (int n = 0; n < 2; ++n) acc[a][b][m][n] = (f32x4){0.f, 0.f, 0.f, 0.f};
    bf16x8 At[4][2], B0[2][2], B1[2][2];
    const char* cA = (const char*)g.A + (size_t)cur.pm * tstep; const char* cB = (const char*)g.Bt + (size_t)cur.pn * tstep;
    S.a_ready(cur);
    if constexpr (SP2) {
        PG8_STAGE(PG8_SB(0, 0), cB, voffB); PG8_STAGE(PG8_SB(0, 1), cB + hstep, voffB); PG8_STAGE(PG8_SA(0, 0), cA, voffA); PG8_STAGE(PG8_SA(0, 1), cA + hstep, voffA);
        if (wr == 1) PG8_BAR;
        PG8_WAIT_V(2); PG8_BAR;
        PG8_STAGE(PG8_SB(1, 0), cB + kstep, voffB); PG8_STAGE(PG8_SA(1, 0), cA + kstep, voffA); PG8_STAGE(PG8_SB(1, 1), cB + hstep + kstep, voffB);
        PG8_WAIT_V(6); PG8_BAR;
    } else {
        PG8_STAGE(PG8_SB(0, 0), cB, voffB); PG8_STAGE(PG8_SA(0, 0), cA, voffA); PG8_STAGE(PG8_SB(0, 1), cB + hstep, voffB); PG8_STAGE(PG8_SA(0, 1), cA + hstep, voffA);
        if (wr == 1) PG8_BAR;
        PG8_WAIT_V(4); PG8_BAR;
        PG8_STAGE(PG8_SB(1, 0), cB + kstep, voffB); PG8_STAGE(PG8_SA(1, 0), cA + kstep, voffA); PG8_STAGE(PG8_SB(1, 1), cB + hstep + kstep, voffB);
        PG8_WAIT_V(6); PG8_BAR;
    }
    for (;;) {
        const bool has_next = S.next(ui + 1, nxt);
        const char* nA = has_next ? (const char*)g.A + (size_t)nxt.pm * tstep : cA; const char* nB = has_next ? (const char*)g.Bt + (size_t)nxt.pn * tstep : cB;
        for (int t = 0; t < nt; t += 2) {
            const bool last = (t == nt - 2);
            const char* a1 = cA + (size_t)(t + 1) * kstep;
            const char* a2 = last ? nA : cA + (size_t)(t + 2) * kstep; const char* b2 = last ? nB : cB + (size_t)(t + 2) * kstep;
            const char* a3 = a2 + kstep; const char* b3 = b2 + kstep;
            if (last && has_next) S.a_ready(nxt);
            if constexpr (SP2) {
            PG8_LDB(B0, 0, 0); PG8_LDB(B1, 0, 1); PG8_SCHED; PG8_LDA(At, 0, 0); PG8_STAGE(PG8_SA(1, 1), a1 + hstep, voffA);
            PG8_WAIT_V(8); PG8_WAIT_L(0); PG8_BAR; PG8_MMA(0, 0, At, B0); PG8_MMA(0, 1, At, B1); PG8_BAR; PG8_SCHED;
            PG8_LDA(At, 0, 1); PG8_STAGE(PG8_SB(0, 0), b2, voffB); PG8_STAGE(PG8_SB(0, 1), b2 + hstep, voffB); PG8_STAGE(PG8_SA(0, 0), a2, voffA);
            PG8_WAIT_V(8); PG8_WAIT_L(0); PG8_BAR; PG8_MMA(1, 0, At, B0); PG8_MMA(1, 1, At, B1); PG8_BAR; PG8_SCHED;
            PG8_LDB(B0, 1, 0); PG8_LDB(B1, 1, 1); PG8_SCHED; PG8_LDA(At, 1, 0); PG8_STAGE(PG8_SA(0, 1), a2 + hstep, voffA);
            PG8_WAIT_V(8); PG8_WAIT_L(0); PG8_BAR; PG8_MMA(0, 0, At, B0); PG8_MMA(0, 1, At, B1); PG8_BAR; PG8_SCHED;
            PG8_LDA(At, 1, 1); PG8_STAGE(PG8_SB(1, 0), b3, voffB); PG8_STAGE(PG8_SB(1, 1), b3 + hstep, voffB); PG8_STAGE(PG8_SA(1, 0), a3, voffA);
            PG8_WAIT_V(8); PG8_WAIT_L(0); PG8_BAR; PG8_MMA(1, 0, At, B0); PG8_MMA(1, 1, At, B1); PG8_BAR; PG8_SCHED;
            } else {
            PG8_LDB(B0, 0, 0); PG8_SCHED; PG8_LDA(At, 0, 0); PG8_STAGE(PG8_SA(1, 1), a1 + hstep, voffA);
            PG8_WAIT_L(8); PG8_BAR; PG8_WAIT_L(0); PG8_MMA(0, 0, At, B0); PG8_BAR; PG8_SCHED;
            PG8_LDB(B1, 0, 1); PG8_STAGE(PG8_SB(0, 0), b2, voffB);
            PG8_BAR; PG8_WAIT_L(0); PG8_MMA(0, 1, At, B1); PG8_BAR;
            PG8_LDA(At, 0, 1); PG8_STAGE(PG8_SA(0, 0), a2, voffA);
            PG8_BAR; PG8_WAIT_L(0); PG8_MMA(1, 0, At, B0); PG8_BAR; PG8_SCHED;
            PG8_STAGE(PG8_SB(0, 1), b2 + hstep, voffB);
            PG8_WAIT_V(6); PG8_BAR; PG8_MMA(1, 1, At, B1); PG8_BAR;
            PG8_LDB(B0, 1, 0); PG8_SCHED; PG8_LDA(At, 1, 0); PG8_STAGE(PG8_SA(0, 1), a2 + hstep, voffA);
            PG8_WAIT_L(8); PG8_BAR; PG8_WAIT_L(0); PG8_MMA(0, 0, At, B0); PG8_BAR; PG8_SCHED;
            PG8_LDB(B1, 1, 1); PG8_STAGE(PG8_SB(1, 0), b3, voffB);
            PG8_BAR; PG8_WAIT_L(0); PG8_MMA(0, 1, At, B1); PG8_BAR;
            PG8_LDA(At, 1, 1); PG8_STAGE(PG8_SA(1, 0), a3, voffA);
            PG8_BAR; PG8_WAIT_L(0); PG8_MMA(1, 0, At, B0); PG8_BAR; PG8_SCHED;
            PG8_STAGE(PG8_SB(1, 1), b3 + hstep, voffB);
            PG8_WAIT_V(6); PG8_BAR; PG8_MMA(1, 1, At, B1); PG8_BAR;
            }
        }
        if constexpr (ALIGN_EPI) { if (wr == 0) PG8_BAR; }
        if constexpr (!Epi::AFTER_DRAIN) { E(acc, cur, wr, wc, fr, fq); S.done(cur); }
        if (!has_next) break;
#pragma unroll
        for (int a = 0; a < 2; ++a)
#pragma unroll
            for (int b = 0; b < 2; ++b)
#pragma unroll
                for (int m = 0; m < 4; ++m)
#pragma unroll
                    for (int n = 0; n < 2; ++n) acc[a][b][m][n] = (f32x4){0.f, 0.f, 0.f, 0.f};
        cur = nxt; cA = nA; cB = nB; ++ui;
        if constexpr (ALIGN_EPI) { if (wr == 1) PG8_BAR; }
    }
    PG8_WAIT_V(0);
    if constexpr (!ALIGN_EPI) { if (wr == 0) PG8_BAR; }
    PG8_BAR;
    if constexpr (Epi::AFTER_DRAIN) { E.fused(acc, cur, wr, wc, fr, fq, lds, wid, lane); S.done(cur); }
#undef PG8_SA
#undef PG8_SB
#undef PG8_STAGE
#undef PG8_LDA
#undef PG8_LDB
#undef PG8_MMA
#undef PG8_WAIT_V
#undef PG8_WAIT_L
#undef PG8_BAR
#undef PG8_SCHED
}
}

#include <hip/hip_cooperative_groups.h>
namespace cg = cooperative_groups;
#ifndef MK_LAUNCHES
#define MK_LAUNCHES 9
#endif
typedef unsigned short bf16_t;
typedef float f32x4 __attribute__((ext_vector_type(4)));
typedef unsigned u32x4 __attribute__((ext_vector_type(4)));
typedef unsigned u32x2 __attribute__((ext_vector_type(2)));
constexpr int NWAVES = 8, NTHR = 512, N_PHASES = 9;
constexpr int T = 16384, SEQ = 4096, DM = 1024, DFF = 2816, NIN = 2560, DRNN = 512, NCHUNK = 64;
constexpr float EPS = 1e-6f;
constexpr size_t MiB = 1u << 20;
constexpr size_t WS_WIN = 0, WS_WOUT = 5 * MiB, WS_WGU2 = 7 * MiB, WS_WD2 = 18 * MiB, WS_SSQ = 24 * MiB, WS_SUM = 27 * MiB, WS_XB = 28 * MiB;
constexpr size_t WS_WGU1 = 60 * MiB, WS_WD1 = 71 * MiB, WS_ACT = 77 * MiB;
constexpr size_t WS_PROJ = 60 * MiB, WS_H = 140 * MiB, WS_P = 172 * MiB, WS_Y = 204 * MiB, WS_END = 236 * MiB;
static_assert(WS_WD2 + (size_t)DM * DFF * 2 <= WS_SSQ && WS_ACT + (size_t)T * DFF * 2 <= WS_Y && WS_PROJ + (size_t)T * NIN * 2 <= WS_H, "d_ws map");
constexpr int LDS_BYTES = 131072;

__device__ __forceinline__ float bf_lo(unsigned u) { return __uint_as_float(u << 16); }
__device__ __forceinline__ float bf_hi(unsigned u) { return __uint_as_float(u & 0xffff0000u); }
__device__ __forceinline__ float bf_1(bf16_t u) { return __uint_as_float((unsigned)u << 16); }
__device__ __forceinline__ unsigned pk_bf16(float lo, float hi) { return pg8::cvt_pk_bf16(lo, hi); }
__device__ __forceinline__ float wave_sum(float v) {
#pragma unroll
    for (int o = 1; o < 64; o <<= 1) v += __shfl_xor(v, o);
    return v;
}
__device__ __forceinline__ float gelu_tanh(float x) {
    const float u = 0.7978845608028654f * (x + 0.044715f * x * x * x);
    const float t = 1.0f - 2.0f * __builtin_amdgcn_rcpf(1.0f + __builtin_amdgcn_exp2f(2.0f * 1.4426950408889634f * u));
    return 0.5f * x * (1.0f + t);
}

struct Args { const float* in[23]; float* out; unsigned char* ws; int ph_lo, ph_hi; };
enum { I_X = 0, I_N1, I_G1, I_U1, I_D1, I_MN, I_WIN, I_CW, I_CB, I_WA, I_BA, I_WX, I_BX, I_LAM, I_QN, I_KN, I_RON, I_AON, I_WOUT, I_N2, I_G2, I_U2, I_D2 };

__device__ __forceinline__ void transpose_item(const float* W, int K, int N, const float* gk, bf16_t* WT, int dst_row0, float* scr, int k0, int n0, int lane) {
#pragma unroll 8
    for (int i = 0; i < 32; ++i) { const int kk = 2 * i + (lane >> 5); float v = W[(size_t)(k0 + kk) * N + n0 + (lane & 31)]; if (gk) v *= gk[k0 + kk]; scr[kk * 33 + (lane & 31)] = v; }
    asm volatile("s_waitcnt lgkmcnt(0)" ::: "memory");
    const int c = lane & 7;
#pragma unroll
    for (int j = 0; j < 4; ++j) { const int n = (lane >> 3) + 8 * j; const float* s = scr + (8 * c) * 33 + n;
        u32x4 o; o.x = pk_bf16(s[0 * 33], s[1 * 33]); o.y = pk_bf16(s[2 * 33], s[3 * 33]); o.z = pk_bf16(s[4 * 33], s[5 * 33]); o.w = pk_bf16(s[6 * 33], s[7 * 33]);
        *(u32x4*)(WT + (size_t)(dst_row0 + n) * K + k0 + 8 * c) = o; }
    asm volatile("s_waitcnt lgkmcnt(0)" ::: "memory");
}
__device__ __forceinline__ void phase_prologue(const Args& a, unsigned char* lds, int gw, int NGW, int wave, int lane) {
    float* scr = (float*)(lds + wave * 16384);
    unsigned char* ws = a.ws;
    constexpr int I_F = (DM / 64) * (DFF / 32), I_D = (DFF / 64) * (DM / 32), I_IN = (DM / 64) * (NIN / 32), I_O = (DM / 64) * (DM / 32);
    constexpr int NITEMS = 6 * I_F + I_IN + I_O;
    for (int it = gw; it < NITEMS; it += NGW) {
        int r = it;
        if (r < 4 * I_F) {
            const int which = r / I_F; r -= which * I_F; const int ffn = which >> 1, up = which & 1;
            const float* W = a.in[ffn ? (up ? I_U2 : I_G2) : (up ? I_U1 : I_G1)]; const float* g = a.in[ffn ? I_N2 : I_N1];
            bf16_t* WT = (bf16_t*)(ws + (ffn ? WS_WGU2 : WS_WGU1));
            const int nblk = DFF / 32, kb = r / nblk, nb = r % nblk, n0 = 32 * nb;
            transpose_item(W, DM, DFF, g, WT, 256 * (n0 / 128) + 128 * up + (n0 % 128), scr, 64 * kb, n0, lane); continue; }
        r -= 4 * I_F;
        if (r < 2 * I_D) {
            const int ffn = r / I_D; r -= ffn * I_D;
            const int nblk = DM / 32, kb = r / nblk, nb = r % nblk, n0 = 32 * nb;
            transpose_item(a.in[ffn ? I_D2 : I_D1], DFF, DM, nullptr, (bf16_t*)(ws + (ffn ? WS_WD2 : WS_WD1)), n0, scr, 64 * kb, n0, lane); continue; }
        r -= 2 * I_D;
        if (r < I_IN) {
            const int nblk = NIN / 32, kb = r / nblk, nb = r % nblk, n0 = 32 * nb, o = n0 % 256, wc = o / 64, bj = (o % 64) / 32;
            transpose_item(a.in[I_WIN], DM, NIN, a.in[I_MN], (bf16_t*)(ws + WS_WIN), (n0 - o) + 128 * bj + 32 * wc, scr, 64 * kb, n0, lane); continue; }
        r -= I_IN;
        { const int nblk = DM / 32, kb = r / nblk, nb = r % nblk, n0 = 32 * nb;
          transpose_item(a.in[I_WOUT], DM, DM, nullptr, (bf16_t*)(ws + WS_WOUT), n0, scr, 64 * kb, n0, lane); }
    }
    const float* x = a.in[I_X]; bf16_t* xb = (bf16_t*)(ws + WS_XB); float* ssq = (float*)(ws + WS_SSQ);
    for (int m = gw; m < T; m += NGW) {
        const f32x4* xr = (const f32x4*)(x + (size_t)m * DM) + lane;
        f32x4 v[4]; float s = 0.f;
#pragma unroll
        for (int j = 0; j < 4; ++j) { v[j] = xr[64 * j]; s += (v[j][0] * v[j][0] + v[j][1] * v[j][1]) + (v[j][2] * v[j][2] + v[j][3] * v[j][3]); }
        s = wave_sum(s);
        u32x2* o8 = (u32x2*)(xb + (size_t)m * DM) + lane;
#pragma unroll
        for (int j = 0; j < 4; ++j) { u32x2 w; w.x = pk_bf16(v[j][0], v[j][1]); w.y = pk_bf16(v[j][2], v[j][3]); o8[64 * j] = w; }
        if (lane < 16) ssq[(size_t)m * 16 + lane] = (lane == 0) ? s : 0.f;
    }
}

__device__ __forceinline__ void rnn_item(const Args& a, int item, float* xcs, int lane) {
    const int b = item >> 9, n = (item >> 6) & 7, c = item & 63, ch = n * 64 + lane;
    unsigned char* ws = a.ws;
    const bf16_t* PROJ = (const bf16_t*)(ws + WS_PROJ); float* Hl = (float*)(ws + WS_H); float* Pc = (float*)(ws + WS_P); float* SUM = (float*)(ws + WS_SUM);
    float wa[64], wx[64];
#pragma unroll
    for (int cc = 0; cc < 64; ++cc) { wa[cc] = a.in[I_WA][(size_t)(n * 64 + cc) * 64 + lane]; wx[cc] = a.in[I_WX][(size_t)(n * 64 + cc) * 64 + lane]; }
    const float cw0 = a.in[I_CW][ch], cw1 = a.in[I_CW][512 + ch], cw2 = a.in[I_CW][1024 + ch], cw3 = a.in[I_CW][1536 + ch], cb = a.in[I_CB][ch];
    const float ba = a.in[I_BA][ch], bx = a.in[I_BX][ch], lam = a.in[I_LAM][ch];
    const float lsl = -(fmaxf(-lam, 0.f) + log1pf(expf(-fabsf(lam))));
    const size_t row0 = (size_t)b * SEQ + (size_t)c * 64;
    const bf16_t* xp = PROJ + row0 * NIN + ch;
    float xm3 = 0.f, xm2 = 0.f, xm1 = 0.f;
    if (c > 0) { xm3 = bf_1(xp[-3 * NIN]); xm2 = bf_1(xp[-2 * NIN]); xm1 = bf_1(xp[-1 * NIN]); }
#pragma unroll 8
    for (int t = 0; t < 64; ++t) { const float x0 = bf_1(xp[(size_t)t * NIN]); xcs[t * 64 + lane] = cb + cw0 * xm3 + cw1 * xm2 + cw2 * xm1 + cw3 * x0; xm3 = xm2; xm2 = xm1; xm1 = x0; }
    asm volatile("s_waitcnt lgkmcnt(0)" ::: "memory");
    float hh = 0.f, P = 1.f;
    for (int t = 0; t < 64; ++t) {
        float ra = ba, ia = bx;
#pragma unroll
        for (int c4 = 0; c4 < 16; ++c4) { const f32x4 xv = *(const f32x4*)(xcs + t * 64 + 4 * c4);
#pragma unroll
            for (int e = 0; e < 4; ++e) { ra += xv[e] * wa[4 * c4 + e]; ia += xv[e] * wx[4 * c4 + e]; } }
        const float own = xcs[t * 64 + lane];
        const float r = 1.0f / (1.0f + expf(-ra)), ig = 1.0f / (1.0f + expf(-ia));
        const float la = 8.0f * r * lsl, av = expf(la), mult = sqrtf(-expm1f(2.0f * la));
        hh = av * hh + mult * (ig * own); P *= av;
        Hl[(row0 + t) * DRNN + ch] = hh; Pc[(row0 + t) * DRNN + ch] = P;
    }
    SUM[(size_t)(b * NCHUNK + c) * DRNN + ch] = P; SUM[(size_t)(4 * NCHUNK + b * NCHUNK + c) * DRNN + ch] = hh;
    asm volatile("s_waitcnt lgkmcnt(0)" ::: "memory");
}

__device__ __forceinline__ void attn_item(const Args& a, int item, int lane) {
    const int b = item >> 9, h = (item >> 6) & 7, qt = item & 63;
    bf16_t* PROJ = (bf16_t*)(a.ws + WS_PROJ);
    const size_t rowb = (size_t)b * SEQ; const int qpos = qt * 64 + lane;
    bf16_t* qp = PROJ + (rowb + qpos) * NIN + 1024 + h * 64;
    float q[64], o[64];
#pragma unroll
    for (int i = 0; i < 8; ++i) { const u32x4 v = ((const u32x4*)qp)[i]; q[8 * i] = bf_lo(v.x); q[8 * i + 1] = bf_hi(v.x); q[8 * i + 2] = bf_lo(v.y); q[8 * i + 3] = bf_hi(v.y);
        q[8 * i + 4] = bf_lo(v.z); q[8 * i + 5] = bf_hi(v.z); q[8 * i + 6] = bf_lo(v.w); q[8 * i + 7] = bf_hi(v.w); }
#pragma unroll
    for (int d = 0; d < 64; ++d) o[d] = 0.f;
    float tail = 0.f;
    for (int j = qt * 64 + 62; j >= 0; --j) {
        const bf16_t* kr = PROJ + (rowb + j) * NIN + 1536 + h * 64;
        float z0 = 0.f, z1 = 0.f;
#pragma unroll
        for (int i = 0; i < 8; ++i) { const u32x4 v = ((const u32x4*)kr)[i];
            z0 += q[8 * i] * bf_lo(v.x); z1 += q[8 * i + 1] * bf_hi(v.x); z0 += q[8 * i + 2] * bf_lo(v.y); z1 += q[8 * i + 3] * bf_hi(v.y);
            z0 += q[8 * i + 4] * bf_lo(v.z); z1 += q[8 * i + 5] * bf_hi(v.z); z0 += q[8 * i + 6] * bf_lo(v.w); z1 += q[8 * i + 7] * bf_hi(v.w); }
        const float z = z0 + z1; const bool act = j < qpos;
        const float sp = fmaxf(z, 0.f) + __logf(1.0f + __expf(-fabsf(z)));
        const float w = act ? __expf((z - sp) + tail) : 0.f;
        tail = act ? tail - sp : tail;
        const bf16_t* vr = kr + 512;
#pragma unroll
        for (int i = 0; i < 8; ++i) { const u32x4 v = ((const u32x4*)vr)[i];
            o[8 * i] += w * bf_lo(v.x); o[8 * i + 1] += w * bf_hi(v.x); o[8 * i + 2] += w * bf_lo(v.y); o[8 * i + 3] += w * bf_hi(v.y);
            o[8 * i + 4] += w * bf_lo(v.z); o[8 * i + 5] += w * bf_hi(v.z); o[8 * i + 6] += w * bf_lo(v.w); o[8 * i + 7] += w * bf_hi(v.w); }
        if (j < qt * 64 && __all(tail < -104.0f)) break;
    }
#pragma unroll
    for (int i = 0; i < 8; ++i) { u32x4 w; w.x = pk_bf16(o[8 * i], o[8 * i + 1]); w.y = pk_bf16(o[8 * i + 2], o[8 * i + 3]); w.z = pk_bf16(o[8 * i + 4], o[8 * i + 5]); w.w = pk_bf16(o[8 * i + 6], o[8 * i + 7]);
        ((u32x4*)qp)[i] = w; }
}

__device__ __forceinline__ void finalize_unit(const Args& a, int unit, float* carry, int tid, int wave, int lane) {
    const int b = unit >> 6, c = unit & 63;
    unsigned char* ws = a.ws;
    const bf16_t* PROJ = (const bf16_t*)(ws + WS_PROJ); const float* Hl = (const float*)(ws + WS_H); const float* Pc = (const float*)(ws + WS_P); const float* SUM = (const float*)(ws + WS_SUM);
    bf16_t* Y = (bf16_t*)(ws + WS_Y);
    { float cr = 0.f; const float* sp = SUM + (size_t)(b * NCHUNK) * DRNN + tid; const float* sh = SUM + (size_t)(4 * NCHUNK + b * NCHUNK) * DRNN + tid;
      for (int cc = 0; cc < c; ++cc) cr = sp[(size_t)cc * DRNN] * cr + sh[(size_t)cc * DRNN];
      carry[tid] = cr; }
    __syncthreads();
    const f32x4 c0 = *(const f32x4*)(carry + 8 * lane), c1 = *(const f32x4*)(carry + 8 * lane + 4);
    const f32x4 gr0 = *(const f32x4*)(a.in[I_RON] + 8 * lane), gr1 = *(const f32x4*)(a.in[I_RON] + 8 * lane + 4);
    const f32x4 ga0 = *(const f32x4*)(a.in[I_AON] + 8 * lane), ga1 = *(const f32x4*)(a.in[I_AON] + 8 * lane + 4);
#pragma unroll 2
    for (int i = 0; i < 8; ++i) {
        const size_t row = (size_t)b * SEQ + (size_t)c * 64 + wave * 8 + i;
        const f32x4 h0 = *(const f32x4*)(Hl + row * DRNN + 8 * lane), h1 = *(const f32x4*)(Hl + row * DRNN + 8 * lane + 4);
        const f32x4 p0 = *(const f32x4*)(Pc + row * DRNN + 8 * lane), p1 = *(const f32x4*)(Pc + row * DRNN + 8 * lane + 4);
        const u32x4 gt = *(const u32x4*)(PROJ + row * NIN + 512 + 8 * lane);
        const u32x4 ya = *(const u32x4*)(PROJ + row * NIN + 1024 + 8 * lane);
        float y[8], z[8];
        y[0] = (h0[0] + p0[0] * c0[0]) * gelu_tanh(bf_lo(gt.x)); y[1] = (h0[1] + p0[1] * c0[1]) * gelu_tanh(bf_hi(gt.x));
        y[2] = (h0[2] + p0[2] * c0[2]) * gelu_tanh(bf_lo(gt.y)); y[3] = (h0[3] + p0[3] * c0[3]) * gelu_tanh(bf_hi(gt.y));
        y[4] = (h1[0] + p1[0] * c1[0]) * gelu_tanh(bf_lo(gt.z)); y[5] = (h1[1] + p1[1] * c1[1]) * gelu_tanh(bf_hi(gt.z));
        y[6] = (h1[2] + p1[2] * c1[2]) * gelu_tanh(bf_lo(gt.w)); y[7] = (h1[3] + p1[3] * c1[3]) * gelu_tanh(bf_hi(gt.w));
        z[0] = bf_lo(ya.x); z[1] = bf_hi(ya.x); z[2] = bf_lo(ya.y); z[3] = bf_hi(ya.y); z[4] = bf_lo(ya.z); z[5] = bf_hi(ya.z); z[6] = bf_lo(ya.w); z[7] = bf_hi(ya.w);
        float sy = 0.f, sz = 0.f;
#pragma unroll
        for (int e = 0; e < 8; ++e) { sy += y[e] * y[e]; sz += z[e] * z[e]; }
        sy = wave_sum(sy); sz = wave_sum(sz);
        const float ry = __builtin_amdgcn_rsqf(sy * (1.0f / 512.0f) + EPS), rz = __builtin_amdgcn_rsqf(sz * (1.0f / 512.0f) + EPS);
        u32x4 wy, wz;
        wy.x = pk_bf16(y[0] * ry * gr0[0], y[1] * ry * gr0[1]); wy.y = pk_bf16(y[2] * ry * gr0[2], y[3] * ry * gr0[3]); wy.z = pk_bf16(y[4] * ry * gr1[0], y[5] * ry * gr1[1]); wy.w = pk_bf16(y[6] * ry * gr1[2], y[7] * ry * gr1[3]);
        wz.x = pk_bf16(z[0] * rz * ga0[0], z[1] * rz * ga0[1]); wz.y = pk_bf16(z[2] * rz * ga0[2], z[3] * rz * ga0[3]); wz.z = pk_bf16(z[4] * rz * ga1[0], z[5] * rz * ga1[1]); wz.w = pk_bf16(z[6] * rz * ga1[2], z[7] * rz * ga1[3]);
        *(u32x4*)(Y + row * DM + 8 * lane) = wy; *(u32x4*)(Y + row * DM + 512 + 8 * lane) = wz;
    }
    __syncthreads();
}

__global__ void __launch_bounds__(NTHR, 2) fwd_megakernel(Args a) {
    extern __shared__ __attribute__((aligned(16))) unsigned char lds[];
    cg::grid_group grid = cg::this_grid();
    const int tid = threadIdx.x, lane = tid & 63, wave = __builtin_amdgcn_readfirstlane(tid >> 6);
    const int G = gridDim.x, bx = blockIdx.x;
    const int gw = bx * NWAVES + wave, NGW = G * NWAVES;
    unsigned char* ws = a.ws;
    PG8_LAS unsigned char* glds = (PG8_LAS unsigned char*)lds;
    const int lo = a.ph_lo, hi = a.ph_hi;
#define IN(k) (lo <= (k) && (k) < hi)
#define SEAM(k) do { if (IN(k) && IN((k) + 1)) grid.sync(); } while (0)
    bf16_t* XB = (bf16_t*)(ws + WS_XB); float* SSQ0 = (float*)(ws + WS_SSQ); float* SSQ1 = SSQ0 + (size_t)T * 16; float* SSQ2 = SSQ1 + (size_t)T * 16;
    bf16_t* ACT = (bf16_t*)(ws + WS_ACT);

    if (IN(0)) { phase_prologue(a, lds, gw, NGW, wave, lane); SEAM(0); }
    if (IN(1)) {
        pg8::Gemm g{XB, (const bf16_t*)(ws + WS_WGU1), T, 2 * DFF, DM}; pg8::StaticOrder S; S.init(T, 2 * DFF, G, bx);
        pg8::EpiSwiGLU E{ACT, DFF, SSQ0};
        pg8::gemm_phase<pg8::EpiSwiGLU, pg8::StaticOrder, true, true>(glds, g, S, E); SEAM(1); }
    if (IN(2)) {
        pg8::Gemm g{ACT, (const bf16_t*)(ws + WS_WD1), T, DM, DFF}; pg8::StaticOrder S; S.init(T, DM, G, bx);
        pg8::EpiResid E{a.in[I_X], a.out, XB, SSQ1, 0.5f};
        pg8::gemm_phase<pg8::EpiResid, pg8::StaticOrder, true, true>(glds, g, S, E); SEAM(2); }
    if (IN(3)) {
        pg8::Gemm g{XB, (const bf16_t*)(ws + WS_WIN), T, NIN, DM}; pg8::StaticOrder S; S.init(T, NIN, G, bx);
        pg8::EpiInProj E{(bf16_t*)(ws + WS_PROJ), SSQ1, a.in[I_QN], a.in[I_KN]};
        pg8::gemm_phase<pg8::EpiInProj, pg8::StaticOrder, true, true>(glds, g, S, E); SEAM(3); }
    if (IN(4)) {
        for (int it = gw; it < 2048; it += NGW) rnn_item(a, it, (float*)(lds + wave * 16384), lane);
        for (int it = gw; it < 2048; it += NGW) attn_item(a, it, lane);
        SEAM(4); }
    if (IN(5)) { for (int u = bx; u < 4 * NCHUNK; u += G) finalize_unit(a, u, (float*)lds, tid, wave, lane); SEAM(5); }
    if (IN(6)) {
        pg8::Gemm g{(const bf16_t*)(ws + WS_Y), (const bf16_t*)(ws + WS_WOUT), T, DM, DM}; pg8::StaticOrder S; S.init(T, DM, G, bx);
        pg8::EpiResid E{a.out, a.out, XB, SSQ2, 1.0f};
        pg8::gemm_phase<pg8::EpiResid, pg8::StaticOrder, true, true>(glds, g, S, E); SEAM(6); }
    if (IN(7)) {
        pg8::Gemm g{XB, (const bf16_t*)(ws + WS_WGU2), T, 2 * DFF, DM}; pg8::StaticOrder S; S.init(T, 2 * DFF, G, bx);
        pg8::EpiSwiGLU E{ACT, DFF, SSQ2};
        pg8::gemm_phase<pg8::EpiSwiGLU, pg8::StaticOrder, true, true>(glds, g, S, E); SEAM(7); }
    if (IN(8)) {
        pg8::Gemm g{ACT, (const bf16_t*)(ws + WS_WD2), T, DM, DFF}; pg8::StaticOrder S; S.init(T, DM, G, bx);
        pg8::EpiResid E{a.out, a.out, nullptr, nullptr, 0.5f};
        pg8::gemm_phase<pg8::EpiResid, pg8::StaticOrder, true, true>(glds, g, S, E); }
#undef IN
#undef SEAM
}

extern "C" void kernel_launch(void* const* d_in, const int* in_sizes, int n_in, void* d_out, int out_size, void* d_ws, size_t ws_size, hipStream_t stream) {
    static int grid = 0;
    if (grid == 0) {
        if (n_in != 23 || in_sizes[0] != T * DM || out_size != T * DM || ws_size < WS_END) { fprintf(stderr, "kernel_launch: unexpected shapes (n_in %d, in0 %d, out %d, ws %zu)\n", n_in, n_in > 0 ? in_sizes[0] : -1, out_size, ws_size); grid = -1; return; }
        int dev = 0, cus = 0, per_cu = 0;
        hipGetDevice(&dev); hipDeviceGetAttribute(&cus, hipDeviceAttributeMultiprocessorCount, dev);
        if (hipFuncSetAttribute((const void*)fwd_megakernel, hipFuncAttributeMaxDynamicSharedMemorySize, LDS_BYTES) != hipSuccess) { fprintf(stderr, "kernel_launch: hipFuncSetAttribute failed\n"); grid = -1; return; }
        if (hipOccupancyMaxActiveBlocksPerMultiprocessor(&per_cu, (const void*)fwd_megakernel, NTHR, LDS_BYTES) != hipSuccess || per_cu < 1) { fprintf(stderr, "kernel_launch: occupancy query says %d\n", per_cu); per_cu = 1; }
        (void)hipGetLastError();
        grid = cus * 1;
        if (grid <= 0) grid = 256;
    }
    if (grid < 0) return;
    Args a{};
    for (int i = 0; i < 23; ++i) a.in[i] = (const float*)d_in[i];
    a.out = (float*)d_out; a.ws = (unsigned char*)d_ws;
#if MK_LAUNCHES == 1
    a.ph_lo = 0; a.ph_hi = N_PHASES;
    void* args[] = {&a};
    hipError_t e = hipLaunchCooperativeKernel((const void*)fwd_megakernel, dim3(grid), dim3(NTHR), args, LDS_BYTES, stream);
    if (e != hipSuccess) fprintf(stderr, "kernel_launch: cooperative launch failed: %s (grid %d)\n", hipGetErrorString(e), grid);
#else
    for (int p = 0; p < N_PHASES; ++p) { a.ph_lo = p; a.ph_hi = p + 1; hipLaunchKernelGGL(fwd_megakernel, dim3(grid), dim3(NTHR), LDS_BYTES, stream, a); }
#endif
}
```

```cpp
#include <hip/hip_runtime.h>
#include <cstdio>
#include <cstdint>
namespace pg8 {
#define PG8_LAS __attribute__((address_space(3)))
typedef unsigned short bf16_t;
typedef short bf16x8 __attribute__((ext_vector_type(8)));
typedef float f32x4 __attribute__((ext_vector_type(4)));
typedef unsigned u32x4 __attribute__((ext_vector_type(4)));
constexpr int BM = 256, BK = 64, HALF = 128, HTB = HALF * BK * 2  , STAGE_BYTES = 8 * HTB, NXCD = 8, WGM = 8;

__host__ __device__ __forceinline__ int lds_byte(int r, int c) { const int st = (r >> 4) * 2 + (c >> 5), rr = r & 15, cc = c & 31, ob = rr * 64 + cc * 2; return st * 1024 + (ob ^ (((ob >> 9) & 1) << 5)); }
__host__ __device__ __forceinline__ void stage_rc(int b, int& R, int& C) { const int st = b / 1024, sb = b % 1024, swz = sb ^ (((sb >> 9) & 1) << 5); R = (st >> 1) * 16 + swz / 64; C = (st & 1) * 32 + (swz % 64) / 2; }
__host__ __device__ __forceinline__ int perm32(int rho) { const int n = rho >> 4, i = rho & 15; return 8 * (i >> 2) + 4 * n + (i & 3); }

struct Unit { int pm, pn; };
struct Gemm { const bf16_t* A; const bf16_t* Bt; int M, N, K; };

struct StaticOrder {
    int nM, nN, nwg, G, c;
    __host__ __device__ void init(int M, int N, int G_, int c_) { nM = M / BM; nN = N / BM; nwg = nM * nN; G = G_; c = c_; }
    __host__ __device__ bool next(int i, Unit& u) const {
        const long L = (long)i * G + c; if (L >= nwg) return false;
        int wgid = (int)L; { const int q = nwg / NXCD, r = nwg % NXCD, xcd = wgid % NXCD, off = wgid / NXCD; wgid = (xcd < r ? xcd * (q + 1) : r * (q + 1) + (xcd - r) * q) + off; }
        const int nig = WGM * nN, gid = wgid / nig, fm = gid * WGM, gsz = (nM - fm) < WGM ? (nM - fm) : WGM;
        u.pm = fm + ((wgid % nig) % gsz); u.pn = (wgid % nig) / gsz; return true;
    }
    __device__ __forceinline__ void a_ready(const Unit&) const {}
    __device__ __forceinline__ void done(const Unit&) const {}
};

__device__ __forceinline__ unsigned cvt_pk_bf16(float lo, float hi) { unsigned r; asm volatile("v_cvt_pk_bf16_f32 %0, %1, %2" : "=v"(r) : "v"(lo), "v"(hi)); return r; }
typedef float f32x2 __attribute__((ext_vector_type(2)));

__device__ __forceinline__ float row_rs(const float* ssq, int row, float inv_n, float eps) {
    const f32x4* p = (const f32x4*)(ssq + (size_t)row * 16);
    const f32x4 a = p[0], b = p[1], c = p[2], d = p[3];
    const float s = (((a[0] + a[1]) + (a[2] + a[3])) + ((b[0] + b[1]) + (b[2] + b[3]))) + (((c[0] + c[1]) + (c[2] + c[3])) + ((d[0] + d[1]) + (d[2] + d[3])));
    return __builtin_amdgcn_rsqf(s * inv_n + eps);
}
__device__ __forceinline__ float silu_mul(float g, float up) { return g * __builtin_amdgcn_rcpf(1.0f + __builtin_amdgcn_exp2f(-1.4426950408889634f * g)) * up; }

struct EpiSwiGLU {
    static constexpr bool PERM = true, AFTER_DRAIN = false;
    bf16_t* O; int ldc; const float* ssq;
    __device__ __forceinline__ void operator()(const f32x4 (&acc)[2][2][4][2], const Unit& u, int wr, int wc, int fr, int fq) const {
        const int row0 = u.pm * BM + wr * 64 + fr, col0 = u.pn * HALF + wc * 32 + 8 * fq;
#pragma unroll
        for (int ai = 0; ai < 2; ++ai)
#pragma unroll
            for (int m = 0; m < 4; ++m) {
                const int row = row0 + ai * HALF + m * 16;
                const float rs = row_rs(ssq, row, 1.0f / 1024.0f, 1e-6f);
                float o[8];
#pragma unroll
                for (int n = 0; n < 2; ++n)
#pragma unroll
                    for (int e = 0; e < 4; ++e) o[n * 4 + e] = silu_mul(acc[ai][0][m][n][e] * rs, acc[ai][1][m][n][e] * rs);
                u32x4 w; w.x = cvt_pk_bf16(o[0], o[1]); w.y = cvt_pk_bf16(o[2], o[3]); w.z = cvt_pk_bf16(o[4], o[5]); w.w = cvt_pk_bf16(o[6], o[7]);
                *(u32x4*)(O + (size_t)row * ldc + col0) = w;
            }
    }
};

struct EpiResid {
    static constexpr bool PERM = true, AFTER_DRAIN = false;
    const float* resid; float* out; bf16_t* xb; float* ssq_out; float alpha;
    __device__ __forceinline__ void operator()(const f32x4 (&acc)[2][2][4][2], const Unit& u, int wr, int wc, int fr, int fq) const {
        const int row0 = u.pm * BM + wr * 64 + fr, col0 = u.pn * BM + wc * 32 + 8 * fq;
#pragma unroll
        for (int ai = 0; ai < 2; ++ai)
#pragma unroll
            for (int m = 0; m < 4; ++m) {
                const int row = row0 + ai * HALF + m * 16; float s = 0.f;
#pragma unroll
                for (int bj = 0; bj < 2; ++bj) {
                    const size_t off = (size_t)row * 1024 + col0 + bj * HALF;
                    const f32x4 r0 = *(const f32x4*)(resid + off), r1 = *(const f32x4*)(resid + off + 4);
                    const f32x4 v0 = r0 + acc[ai][bj][m][0] * alpha, v1 = r1 + acc[ai][bj][m][1] * alpha;
                    *(f32x4*)(out + off) = v0; *(f32x4*)(out + off + 4) = v1;
                    if (xb) { u32x4 w; w.x = cvt_pk_bf16(v0[0], v0[1]); w.y = cvt_pk_bf16(v0[2], v0[3]); w.z = cvt_pk_bf16(v1[0], v1[1]); w.w = cvt_pk_bf16(v1[2], v1[3]); *(u32x4*)(xb + off) = w; }
                    s += ((v0[0] * v0[0] + v0[1] * v0[1]) + (v0[2] * v0[2] + v0[3] * v0[3])) + ((v1[0] * v1[0] + v1[1] * v1[1]) + (v1[2] * v1[2] + v1[3] * v1[3]));
                }
                if (ssq_out) { s += __shfl_xor(s, 16); s += __shfl_xor(s, 32); if (fq == 0) ssq_out[(size_t)row * 16 + u.pn * 4 + wc] = s; }
            }
    }
};

struct EpiInProj {
    static constexpr bool PERM = true, AFTER_DRAIN = false;
    bf16_t* O; const float* ssq; const float* qn; const float* kn;
    __device__ __forceinline__ void operator()(const f32x4 (&acc)[2][2][4][2], const Unit& u, int wr, int wc, int fr, int fq) const {
        const int row0 = u.pm * BM + wr * 64 + fr, col0 = u.pn * BM + wc * 64 + 8 * fq;
        const bool isq = (u.pn == 4 || u.pn == 5), isk = (u.pn == 6 || u.pn == 7), hn = isq || isk;
        f32x4 gn[2][2];
#pragma unroll
        for (int bj = 0; bj < 2; ++bj)
#pragma unroll
            for (int n = 0; n < 2; ++n) { gn[bj][n] = (f32x4){1.f, 1.f, 1.f, 1.f}; if (hn) gn[bj][n] = *(const f32x4*)((isq ? qn : kn) + 32 * bj + 8 * fq + 4 * n) * (isq ? 0.125f : 1.0f); }
#pragma unroll
        for (int ai = 0; ai < 2; ++ai)
#pragma unroll
            for (int m = 0; m < 4; ++m) {
                const int row = row0 + ai * HALF + m * 16;
                const float rs = row_rs(ssq, row, 1.0f / 1024.0f, 1e-6f);
                f32x4 v[2][2]; float s = 0.f;
#pragma unroll
                for (int bj = 0; bj < 2; ++bj)
#pragma unroll
                    for (int n = 0; n < 2; ++n) { v[bj][n] = acc[ai][bj][m][n] * rs; const f32x4 t = v[bj][n]; s += (t[0] * t[0] + t[1] * t[1]) + (t[2] * t[2] + t[3] * t[3]); }
                if (hn) { s += __shfl_xor(s, 16); s += __shfl_xor(s, 32); const float rq = __builtin_amdgcn_rsqf(s * (1.0f / 64.0f) + 1e-6f);
#pragma unroll
                    for (int bj = 0; bj < 2; ++bj)
#pragma unroll
                        for (int n = 0; n < 2; ++n) v[bj][n] = v[bj][n] * rq * gn[bj][n]; }
#pragma unroll
                for (int bj = 0; bj < 2; ++bj) { u32x4 w; w.x = cvt_pk_bf16(v[bj][0][0], v[bj][0][1]); w.y = cvt_pk_bf16(v[bj][0][2], v[bj][0][3]); w.z = cvt_pk_bf16(v[bj][1][0], v[bj][1][1]); w.w = cvt_pk_bf16(v[bj][1][2], v[bj][1][3]);
                    *(u32x4*)(O + (size_t)row * 2560 + col0 + 32 * bj) = w; }
            }
    }
};

template <class Epi, class Sched, bool ALIGN_EPI = false, bool SP2 = false>
__device__ __forceinline__ void gemm_phase(PG8_LAS unsigned char* lds, const Gemm g, const Sched& S, const Epi& E) {
    const int tid = threadIdx.x, wid = __builtin_amdgcn_readfirstlane(tid >> 6), lane = tid & 63, wr = wid >> 2, wc = wid & 3, fr = lane & 15, fq = lane >> 4;
    const int K = g.K, nt = K / BK;
    unsigned voffA[2], voffB[2];
#pragma unroll
    for (int i = 0; i < 2; ++i) { int R, C; stage_rc(tid * 16 + i * 8192, R, C); const int Rb = Epi::PERM ? ((R & ~31) + perm32(R & 31)) : R;
        voffA[i] = (unsigned)(R * K + C) * 2u; voffB[i] = (unsigned)(Rb * K + C) * 2u; }
    const size_t kstep = (size_t)(BK * 2);
    const size_t hstep = (size_t)HALF * K * 2;
    const size_t tstep = 2 * hstep;
    const unsigned ldsw = (unsigned)wid * 1024u;
    const int aoff = lds_byte(wr * 64 + fr, fq * 8), boff = lds_byte(wc * 32 + fr, fq * 8);
#define PG8_SA(b, h) (((b) * 2 + (h)) * HTB)
#define PG8_SB(b, h) ((4 + (b) * 2 + (h)) * HTB)
#define PG8_STAGE(bufoff, gbase, voff) do { _Pragma("unroll") for (int _i = 0; _i < 2; ++_i) \
        __builtin_amdgcn_global_load_lds((const unsigned*)((const char*)(gbase) + (voff)[_i]), (PG8_LAS unsigned*)(lds + (bufoff) + ldsw + _i * 8192), 16, 0, 0); } while (0)
#define PG8_LDA(dst, b, h) do { _Pragma("unroll") for (int m = 0; m < 4; ++m) _Pragma("unroll") for (int k = 0; k < 2; ++k) dst[m][k] = *(const PG8_LAS bf16x8*)(lds + PG8_SA(b, h) + aoff + m * 2048 + k * 1024); } while (0)
#define PG8_LDB(dst, b, h) do { _Pragma("unroll") for (int n = 0; n < 2; ++n) _Pragma("unroll") for (int k = 0; k < 2; ++k) dst[n][k] = *(const PG8_LAS bf16x8*)(lds + PG8_SB(b, h) + boff + n * 2048 + k * 1024); } while (0)
#define PG8_MMA(ai, bj, At, Bt) do { __builtin_amdgcn_s_setprio(1); _Pragma("unroll") for (int m = 0; m < 4; ++m) _Pragma("unroll") for (int n = 0; n < 2; ++n) _Pragma("unroll") for (int k = 0; k < 2; ++k) \
        acc[ai][bj][m][n] = __builtin_amdgcn_mfma_f32_16x16x32_bf16(Bt[n][k], At[m][k], acc[ai][bj][m][n], 0, 0, 0); __builtin_amdgcn_s_setprio(0); } while (0)
#define PG8_WAIT_V(n) asm volatile("s_waitcnt vmcnt(" #n ")" ::: "memory")
#define PG8_WAIT_L(n) asm volatile("s_waitcnt lgkmcnt(" #n ")" ::: "memory")
#define PG8_BAR __builtin_amdgcn_s_barrier()
#define PG8_SCHED __builtin_amdgcn_sched_barrier(0)
    Unit cur, nxt; int ui = 0;
    if (!S.next(0, cur)) return;
    f32x4 acc[2][2][4][2];
#pragma unroll
    for (int a = 0; a < 2; ++a)
#pragma unroll
        for (int b = 0; b < 2; ++b)
#pragma unroll
            for (int m = 0; m < 4; ++m)
#pragma unroll
                for (int n = 0; n < 2; ++n) acc[a][b][m][n] = (f32x4){0.f, 0.f, 0.f, 0.f};
    bf16x8 At[4][2], B0[2][2], B1[2][2];
    const char* cA = (const char*)g.A + (size_t)cur.pm * tstep; const char* cB = (const char*)g.Bt + (size_t)cur.pn * tstep;
    S.a_ready(cur);
    if constexpr (SP2) {
        PG8_STAGE(PG8_SB(0, 0), cB, voffB); PG8_STAGE(PG8_SB(0, 1), cB + hstep, voffB); PG8_STAGE(PG8_SA(0, 0), cA, voffA); PG8_STAGE(PG8_SA(0, 1), cA + hstep, voffA);
        if (wr == 1) PG8_BAR;
        PG8_WAIT_V(2); PG8_BAR;
        PG8_STAGE(PG8_SB(1, 0), cB + kstep, voffB); PG8_STAGE(PG8_SA(1, 0), cA + kstep, voffA); PG8_STAGE(PG8_SB(1, 1), cB + hstep + kstep, voffB);
        PG8_WAIT_V(6); PG8_BAR;
    } else {
        PG8_STAGE(PG8_SB(0, 0), cB, voffB); PG8_STAGE(PG8_SA(0, 0), cA, voffA); PG8_STAGE(PG8_SB(0, 1), cB + hstep, voffB); PG8_STAGE(PG8_SA(0, 1), cA + hstep, voffA);
        if (wr == 1) PG8_BAR;
        PG8_WAIT_V(4); PG8_BAR;
        PG8_STAGE(PG8_SB(1, 0), cB + kstep, voffB); PG8_STAGE(PG8_SA(1, 0), cA + kstep, voffA); PG8_STAGE(PG8_SB(1, 1), cB + hstep + kstep, voffB);
        PG8_WAIT_V(6); PG8_BAR;
    }
    for (;;) {
        const bool has_next = S.next(ui + 1, nxt);
        const char* nA = has_next ? (const char*)g.A + (size_t)nxt.pm * tstep : cA; const char* nB = has_next ? (const char*)g.Bt + (size_t)nxt.pn * tstep : cB;
        for (int t = 0; t < nt; t += 2) {
            const bool last = (t == nt - 2);
            const char* a1 = cA + (size_t)(t + 1) * kstep;
            const char* a2 = last ? nA : cA + (size_t)(t + 2) * kstep; const char* b2 = last ? nB : cB + (size_t)(t + 2) * kstep;
            const char* a3 = a2 + kstep; const char* b3 = b2 + kstep;
            if (last && has_next) S.a_ready(nxt);
            if constexpr (SP2) {
            PG8_LDB(B0, 0, 0); PG8_LDB(B1, 0, 1); PG8_SCHED; PG8_LDA(At, 0, 0); PG8_STAGE(PG8_SA(1, 1), a1 + hstep, voffA);
            PG8_WAIT_V(8); PG8_WAIT_L(0); PG8_BAR; PG8_MMA(0, 0, At, B0); PG8_MMA(0, 1, At, B1); PG8_BAR; PG8_SCHED;
            PG8_LDA(At, 0, 1); PG8_STAGE(PG8_SB(0, 0), b2, voffB); PG8_STAGE(PG8_SB(0, 1), b2 + hstep, voffB); PG8_STAGE(PG8_SA(0, 0), a2, voffA);
            PG8_WAIT_V(8); PG8_WAIT_L(0); PG8_BAR; PG8_MMA(1, 0, At, B0); PG8_MMA(1, 1, At, B1); PG8_BAR; PG8_SCHED;
            PG8_LDB(B0, 1, 0); PG8_LDB(B1, 1, 1); PG8_SCHED; PG8_LDA(At, 1, 0); PG8_STAGE(PG8_SA(0, 1), a2 + hstep, voffA);
            PG8_WAIT_V(8); PG8_WAIT_L(0); PG8_BAR; PG8_MMA(0, 0, At, B0); PG8_MMA(0, 1, At, B1); PG8_BAR; PG8_SCHED;
            PG8_LDA(At, 1, 1); PG8_STAGE(PG8_SB(1, 0), b3, voffB); PG8_STAGE(PG8_SB(1, 1), b3 + hstep, voffB); PG8_STAGE(PG8_SA(1, 0), a3, voffA);
            PG8_WAIT_V(8); PG8_WAIT_L(0); PG8_BAR; PG8_MMA(1, 0, At, B0); PG8_MMA(1, 1, At, B1); PG8_BAR; PG8_SCHED;
            } else {
            PG8_LDB(B0, 0, 0); PG8_SCHED; PG8_LDA(At, 0, 0); PG8_STAGE(PG8_SA(1, 1), a1 + hstep, voffA);
            PG8_WAIT_L(8); PG8_BAR; PG8_WAIT_L(0); PG8_MMA(0, 0, At, B0); PG8_BAR; PG8_SCHED;
            PG8_LDB(B1, 0, 1); PG8_STAGE(PG8_SB(0, 0), b2, voffB);
            PG8_BAR; PG8_WAIT_L(0); PG8_MMA(0, 1, At, B1); PG8_BAR;
            PG8_LDA(At, 0, 1); PG8_STAGE(PG8_SA(0, 0), a2, voffA);
            PG8_BAR; PG8_WAIT_L(0); PG8_MMA(1, 0, At, B0); PG8_BAR; PG8_SCHED;
            PG8_STAGE(PG8_SB(0, 1), b2 + hstep, voffB);
            PG8_WAIT_V(6); PG8_BAR; PG8_MMA(1, 1, At, B1); PG8_BAR;
            PG8_LDB(B0, 1, 0); PG8_SCHED; PG8_LDA(At, 1, 0); PG8_STAGE(PG8_SA(0, 1), a2 + hstep, voffA);
            PG8_WAIT_L(8); PG8_BAR; PG8_WAIT_L(0); PG8_MMA(0, 0, At, B0); PG8_BAR; PG8_SCHED;
            PG8_LDB(B1, 1, 1); PG8_STAGE(PG8_SB(1, 0), b3, voffB);
            PG8_BAR; PG8_WAIT_L(0); PG8_MMA(0, 1, At, B1); PG8_BAR;
            PG8_LDA(At, 1, 1); PG8_STAGE(PG8_SA(1, 0), a3, voffA);
            PG8_BAR; PG8_WAIT_L(0); PG8_MMA(1, 0, At, B0); PG8_BAR; PG8_SCHED;
            PG8_STAGE(PG8_SB(1, 1), b3 + hstep, voffB);
            PG8_WAIT_V(6); PG8_BAR; PG8_MMA(1, 1, At, B1); PG8_BAR;
            }
        }
        if constexpr (ALIGN_EPI) { if (wr == 0) PG8_BAR; }
        if constexpr (!Epi::AFTER_DRAIN) { E(acc, cur, wr, wc, fr, fq); S.done(cur); }
        if (!has_next) break;
#pragma unroll
        for (int a = 0; a < 2; ++a)
#pragma unroll
            for (int b = 0; b < 2; ++b)
#pragma unroll
                for (int m = 0; m < 4; ++m)
#pragma unroll
                    for (int n = 0; n < 2; ++n) acc[a][b][m][n] = (f32x4){0.f, 0.f, 0.f, 0.f};
        cur = nxt; cA = nA; cB = nB; ++ui;
        if constexpr (ALIGN_EPI) { if (wr == 1) PG8_BAR; }
    }
    PG8_WAIT_V(0);
    if constexpr (!ALIGN_EPI) { if (wr == 0) PG8_BAR; }
    PG8_BAR;
    if constexpr (Epi::AFTER_DRAIN) { E.fused(acc, cur, wr, wc, fr, fq, lds, wid, lane); S.done(cur); }
#undef PG8_SA
#undef PG8_SB
#undef PG8_STAGE
#undef PG8_LDA
#undef PG8_LDB
#undef PG8_MMA
#undef PG8_WAIT_V
#undef PG8_WAIT_L
#undef PG8_BAR
#undef PG8_SCHED
}
}

#include <hip/hip_cooperative_groups.h>
namespace cg = cooperative_groups;
#ifndef MK_LAUNCHES
#define MK_LAUNCHES 1
#endif
typedef unsigned short bf16_t;
typedef float f32x4 __attribute__((ext_vector_type(4)));
typedef unsigned u32x4 __attribute__((ext_vector_type(4)));
typedef unsigned u32x2 __attribute__((ext_vector_type(2)));
constexpr int NWAVES = 8, NTHR = 512, N_PHASES = 9;
constexpr int T = 16384, SEQ = 4096, DM = 1024, DFF = 2816, NIN = 2560, DRNN = 512, NCHUNK = 64;
constexpr float EPS = 1e-6f;
constexpr size_t MiB = 1u << 20;
constexpr size_t WS_WIN = 0, WS_WOUT = 5 * MiB, WS_WGU2 = 7 * MiB, WS_WD2 = 18 * MiB, WS_SSQ = 24 * MiB, WS_SUM = 27 * MiB, WS_XB = 28 * MiB;
constexpr size_t WS_WGU1 = 60 * MiB, WS_WD1 = 71 * MiB, WS_ACT = 77 * MiB;
constexpr size_t WS_PROJ = 60 * MiB, WS_H = 140 * MiB, WS_P = 172 * MiB, WS_Y = 204 * MiB, WS_END = 236 * MiB;
static_assert(WS_WD2 + (size_t)DM * DFF * 2 <= WS_SSQ && WS_ACT + (size_t)T * DFF * 2 <= WS_Y && WS_PROJ + (size_t)T * NIN * 2 <= WS_H, "d_ws map");
constexpr int LDS_BYTES = 131072;

__device__ __forceinline__ float bf_lo(unsigned u) { return __uint_as_float(u << 16); }
__device__ __forceinline__ float bf_hi(unsigned u) { return __uint_as_float(u & 0xffff0000u); }
__device__ __forceinline__ float bf_1(bf16_t u) { return __uint_as_float((unsigned)u << 16); }
__device__ __forceinline__ unsigned pk_bf16(float lo, float hi) { return pg8::cvt_pk_bf16(lo, hi); }
__device__ __forceinline__ float wave_sum(float v) {
#pragma unroll
    for (int o = 1; o < 64; o <<= 1) v += __shfl_xor(v, o);
    return v;
}
__device__ __forceinline__ float gelu_tanh(float x) {
    const float u = 0.7978845608028654f * (x + 0.044715f * x * x * x);
    const float t = 1.0f - 2.0f * __builtin_amdgcn_rcpf(1.0f + __builtin_amdgcn_exp2f(2.0f * 1.4426950408889634f * u));
    return 0.5f * x * (1.0f + t);
}

struct Args { const float* in[23]; float* out; unsigned char* ws; int ph_lo, ph_hi; };
enum { I_X = 0, I_N1, I_G1, I_U1, I_D1, I_MN, I_WIN, I_CW, I_CB, I_WA, I_BA, I_WX, I_BX, I_LAM, I_QN, I_KN, I_RON, I_AON, I_WOUT, I_N2, I_G2, I_U2, I_D2 };

__device__ __forceinline__ void transpose_item(const float* W, int K, int N, const float* gk, bf16_t* WT, int dst_row0, float* scr, int k0, int n0, int lane) {
#pragma unroll 8
    for (int i = 0; i < 32; ++i) { const int kk = 2 * i + (lane >> 5); float v = W[(size_t)(k0 + kk) * N + n0 + (lane & 31)]; if (gk) v *= gk[k0 + kk]; scr[kk * 33 + (lane & 31)] = v; }
    asm volatile("s_waitcnt lgkmcnt(0)" ::: "memory");
    const int c = lane & 7;
#pragma unroll
    for (int j = 0; j < 4; ++j) { const int n = (lane >> 3) + 8 * j; const float* s = scr + (8 * c) * 33 + n;
        u32x4 o; o.x = pk_bf16(s[0 * 33], s[1 * 33]); o.y = pk_bf16(s[2 * 33], s[3 * 33]); o.z = pk_bf16(s[4 * 33], s[5 * 33]); o.w = pk_bf16(s[6 * 33], s[7 * 33]);
        *(u32x4*)(WT + (size_t)(dst_row0 + n) * K + k0 + 8 * c) = o; }
    asm volatile("s_waitcnt lgkmcnt(0)" ::: "memory");
}
__device__ __forceinline__ void phase_prologue(const Args& a, unsigned char* lds, int gw, int NGW, int wave, int lane) {
    float* scr = (float*)(lds + wave * 16384);
    unsigned char* ws = a.ws;
    constexpr int I_F = (DM / 64) * (DFF / 32), I_D = (DFF / 64) * (DM / 32), I_IN = (DM / 64) * (NIN / 32), I_O = (DM / 64) * (DM / 32);
    constexpr int NITEMS = 6 * I_F + I_IN + I_O;
    for (int it = gw; it < NITEMS; it += NGW) {
        int r = it;
        if (r < 4 * I_F) {
            const int which = r / I_F; r -= which * I_F; const int ffn = which >> 1, up = which & 1;
            const float* W = a.in[ffn ? (up ? I_U2 : I_G2) : (up ? I_U1 : I_G1)]; const float* g = a.in[ffn ? I_N2 : I_N1];
            bf16_t* WT = (bf16_t*)(ws + (ffn ? WS_WGU2 : WS_WGU1));
            const int nblk = DFF / 32, kb = r / nblk, nb = r % nblk, n0 = 32 * nb;
            transpose_item(W, DM, DFF, g, WT, 256 * (n0 / 128) + 128 * up + (n0 % 128), scr, 64 * kb, n0, lane); continue; }
        r -= 4 * I_F;
        if (r < 2 * I_D) {
            const int ffn = r / I_D; r -= ffn * I_D;
            const int nblk = DM / 32, kb = r / nblk, nb = r % nblk, n0 = 32 * nb;
            transpose_item(a.in[ffn ? I_D2 : I_D1], DFF, DM, nullptr, (bf16_t*)(ws + (ffn ? WS_WD2 : WS_WD1)), n0, scr, 64 * kb, n0, lane); continue; }
        r -= 2 * I_D;
        if (r < I_IN) {
            const int nblk = NIN / 32, kb = r / nblk, nb = r % nblk, n0 = 32 * nb, o = n0 % 256, wc = o / 64, bj = (o % 64) / 32;
            transpose_item(a.in[I_WIN], DM, NIN, a.in[I_MN], (bf16_t*)(ws + WS_WIN), (n0 - o) + 128 * bj + 32 * wc, scr, 64 * kb, n0, lane); continue; }
        r -= I_IN;
        { const int nblk = DM / 32, kb = r / nblk, nb = r % nblk, n0 = 32 * nb;
          transpose_item(a.in[I_WOUT], DM, DM, nullptr, (bf16_t*)(ws + WS_WOUT), n0, scr, 64 * kb, n0, lane); }
    }
    const float* x = a.in[I_X]; bf16_t* xb = (bf16_t*)(ws + WS_XB); float* ssq = (float*)(ws + WS_SSQ);
    for (int m = gw; m < T; m += NGW) {
        const f32x4* xr = (const f32x4*)(x + (size_t)m * DM) + lane;
        f32x4 v[4]; float s = 0.f;
#pragma unroll
        for (int j = 0; j < 4; ++j) { v[j] = xr[64 * j]; s += (v[j][0] * v[j][0] + v[j][1] * v[j][1]) + (v[j][2] * v[j][2] + v[j][3] * v[j][3]); }
        s = wave_sum(s);
        u32x2* o8 = (u32x2*)(xb + (size_t)m * DM) + lane;
#pragma unroll
        for (int j = 0; j < 4; ++j) { u32x2 w; w.x = pk_bf16(v[j][0], v[j][1]); w.y = pk_bf16(v[j][2], v[j][3]); o8[64 * j] = w; }
        if (lane < 16) ssq[(size_t)m * 16 + lane] = (lane == 0) ? s : 0.f;
    }
}

__device__ __forceinline__ void rnn_item(const Args& a, int item, float* xcs, int lane) {
    const int b = item >> 9, n = (item >> 6) & 7, c = item & 63, ch = n * 64 + lane;
    unsigned char* ws = a.ws;
    const bf16_t* PROJ = (const bf16_t*)(ws + WS_PROJ); float* Hl = (float*)(ws + WS_H); float* Pc = (float*)(ws + WS_P); float* SUM = (float*)(ws + WS_SUM);
    float wa[64], wx[64];
#pragma unroll
    for (int cc = 0; cc < 64; ++cc) { wa[cc] = a.in[I_WA][(size_t)(n * 64 + cc) * 64 + lane]; wx[cc] = a.in[I_WX][(size_t)(n * 64 + cc) * 64 + lane]; }
    const float cw0 = a.in[I_CW][ch], cw1 = a.in[I_CW][512 + ch], cw2 = a.in[I_CW][1024 + ch], cw3 = a.in[I_CW][1536 + ch], cb = a.in[I_CB][ch];
    const float ba = a.in[I_BA][ch], bx = a.in[I_BX][ch], lam = a.in[I_LAM][ch];
    const float lsl = -(fmaxf(-lam, 0.f) + log1pf(expf(-fabsf(lam))));
    const size_t row0 = (size_t)b * SEQ + (size_t)c * 64;
    const bf16_t* xp = PROJ + row0 * NIN + ch;
    float xm3 = 0.f, xm2 = 0.f, xm1 = 0.f;
    if (c > 0) { xm3 = bf_1(xp[-3 * NIN]); xm2 = bf_1(xp[-2 * NIN]); xm1 = bf_1(xp[-1 * NIN]); }
#pragma unroll 8
    for (int t = 0; t < 64; ++t) { const float x0 = bf_1(xp[(size_t)t * NIN]); xcs[t * 64 + lane] = cb + cw0 * xm3 + cw1 * xm2 + cw2 * xm1 + cw3 * x0; xm3 = xm2; xm2 = xm1; xm1 = x0; }
    asm volatile("s_waitcnt lgkmcnt(0)" ::: "memory");
    float hh = 0.f, P = 1.f;
    for (int t = 0; t < 64; ++t) {
        float ra = ba, ia = bx;
#pragma unroll
        for (int c4 = 0; c4 < 16; ++c4) { const f32x4 xv = *(const f32x4*)(xcs + t * 64 + 4 * c4);
#pragma unroll
            for (int e = 0; e < 4; ++e) { ra += xv[e] * wa[4 * c4 + e]; ia += xv[e] * wx[4 * c4 + e]; } }
        const float own = xcs[t * 64 + lane];
        const float r = 1.0f / (1.0f + expf(-ra)), ig = 1.0f / (1.0f + expf(-ia));
        const float la = 8.0f * r * lsl, av = expf(la), mult = sqrtf(-expm1f(2.0f * la));
        hh = av * hh + mult * (ig * own); P *= av;
        Hl[(row0 + t) * DRNN + ch] = hh; Pc[(row0 + t) * DRNN + ch] = P;
    }
    SUM[(size_t)(b * NCHUNK + c) * DRNN + ch] = P; SUM[(size_t)(4 * NCHUNK + b * NCHUNK + c) * DRNN + ch] = hh;
    asm volatile("s_waitcnt lgkmcnt(0)" ::: "memory");
}

__device__ __forceinline__ void attn_item(const Args& a, int item, int lane) {
    const int b = item >> 9, h = (item >> 6) & 7, qt = item & 63;
    bf16_t* PROJ = (bf16_t*)(a.ws + WS_PROJ);
    const size_t rowb = (size_t)b * SEQ; const int qpos = qt * 64 + lane;
    bf16_t* qp = PROJ + (rowb + qpos) * NIN + 1024 + h * 64;
    float q[64], o[64];
#pragma unroll
    for (int i = 0; i < 8; ++i) { const u32x4 v = ((const u32x4*)qp)[i]; q[8 * i] = bf_lo(v.x); q[8 * i + 1] = bf_hi(v.x); q[8 * i + 2] = bf_lo(v.y); q[8 * i + 3] = bf_hi(v.y);
        q[8 * i + 4] = bf_lo(v.z); q[8 * i + 5] = bf_hi(v.z); q[8 * i + 6] = bf_lo(v.w); q[8 * i + 7] = bf_hi(v.w); }
#pragma unroll
    for (int d = 0; d < 64; ++d) o[d] = 0.f;
    float tail = 0.f;
    for (int j = qt * 64 + 62; j >= 0; --j) {
        const bf16_t* kr = PROJ + (rowb + j) * NIN + 1536 + h * 64;
        float z0 = 0.f, z1 = 0.f;
#pragma unroll
        for (int i = 0; i < 8; ++i) { const u32x4 v = ((const u32x4*)kr)[i];
            z0 += q[8 * i] * bf_lo(v.x); z1 += q[8 * i + 1] * bf_hi(v.x); z0 += q[8 * i + 2] * bf_lo(v.y); z1 += q[8 * i + 3] * bf_hi(v.y);
            z0 += q[8 * i + 4] * bf_lo(v.z); z1 += q[8 * i + 5] * bf_hi(v.z); z0 += q[8 * i + 6] * bf_lo(v.w); z1 += q[8 * i + 7] * bf_hi(v.w); }
        const float z = z0 + z1; const bool act = j < qpos;
        const float sp = fmaxf(z, 0.f) + __logf(1.0f + __expf(-fabsf(z)));
        const float w = act ? __expf((z - sp) + tail) : 0.f;
        tail = act ? tail - sp : tail;
        const bf16_t* vr = kr + 512;
#pragma unroll
        for (int i = 0; i < 8; ++i) { const u32x4 v = ((const u32x4*)vr)[i];
            o[8 * i] += w * bf_lo(v.x); o[8 * i + 1] += w * bf_hi(v.x); o[8 * i + 2] += w * bf_lo(v.y); o[8 * i + 3] += w * bf_hi(v.y);
            o[8 * i + 4] += w * bf_lo(v.z); o[8 * i + 5] += w * bf_hi(v.z); o[8 * i + 6] += w * bf_lo(v.w); o[8 * i + 7] += w * bf_hi(v.w); }
        if (j < qt * 64 && __all(tail < -104.0f)) break;
    }
#pragma unroll
    for (int i = 0; i < 8; ++i) { u32x4 w; w.x = pk_bf16(o[8 * i], o[8 * i + 1]); w.y = pk_bf16(o[8 * i + 2], o[8 * i + 3]); w.z = pk_bf16(o[8 * i + 4], o[8 * i + 5]); w.w = pk_bf16(o[8 * i + 6], o[8 * i + 7]);
        ((u32x4*)qp)[i] = w; }
}

__device__ __forceinline__ void finalize_unit(const Args& a, int unit, float* carry, int tid, int wave, int lane) {
    const int b = unit >> 6, c = unit & 63;
    unsigned char* ws = a.ws;
    const bf16_t* PROJ = (const bf16_t*)(ws + WS_PROJ); const float* Hl = (const float*)(ws + WS_H); const float* Pc = (const float*)(ws + WS_P); const float* SUM = (const float*)(ws + WS_SUM);
    bf16_t* Y = (bf16_t*)(ws + WS_Y);
    { float cr = 0.f; const float* sp = SUM + (size_t)(b * NCHUNK) * DRNN + tid; const float* sh = SUM + (size_t)(4 * NCHUNK + b * NCHUNK) * DRNN + tid;
      for (int cc = 0; cc < c; ++cc) cr = sp[(size_t)cc * DRNN] * cr + sh[(size_t)cc * DRNN];
      carry[tid] = cr; }
    __syncthreads();
    const f32x4 c0 = *(const f32x4*)(carry + 8 * lane), c1 = *(const f32x4*)(carry + 8 * lane + 4);
    const f32x4 gr0 = *(const f32x4*)(a.in[I_RON] + 8 * lane), gr1 = *(const f32x4*)(a.in[I_RON] + 8 * lane + 4);
    const f32x4 ga0 = *(const f32x4*)(a.in[I_AON] + 8 * lane), ga1 = *(const f32x4*)(a.in[I_AON] + 8 * lane + 4);
#pragma unroll 2
    for (int i = 0; i < 8; ++i) {
        const size_t row = (size_t)b * SEQ + (size_t)c * 64 + wave * 8 + i;
        const f32x4 h0 = *(const f32x4*)(Hl + row * DRNN + 8 * lane), h1 = *(const f32x4*)(Hl + row * DRNN + 8 * lane + 4);
        const f32x4 p0 = *(const f32x4*)(Pc + row * DRNN + 8 * lane), p1 = *(const f32x4*)(Pc + row * DRNN + 8 * lane + 4);
        const u32x4 gt = *(const u32x4*)(PROJ + row * NIN + 512 + 8 * lane);
        const u32x4 ya = *(const u32x4*)(PROJ + row * NIN + 1024 + 8 * lane);
        float y[8], z[8];
        y[0] = (h0[0] + p0[0] * c0[0]) * gelu_tanh(bf_lo(gt.x)); y[1] = (h0[1] + p0[1] * c0[1]) * gelu_tanh(bf_hi(gt.x));
        y[2] = (h0[2] + p0[2] * c0[2]) * gelu_tanh(bf_lo(gt.y)); y[3] = (h0[3] + p0[3] * c0[3]) * gelu_tanh(bf_hi(gt.y));
        y[4] = (h1[0] + p1[0] * c1[0]) * gelu_tanh(bf_lo(gt.z)); y[5] = (h1[1] + p1[1] * c1[1]) * gelu_tanh(bf_hi(gt.z));
        y[6] = (h1[2] + p1[2] * c1[2]) * gelu_tanh(bf_lo(gt.w)); y[7] = (h1[3] + p1[3] * c1[3]) * gelu_tanh(bf_hi(gt.w));
        z[0] = bf_lo(ya.x); z[1] = bf_hi(ya.x); z[2] = bf_lo(ya.y); z[3] = bf_hi(ya.y); z[4] = bf_lo(ya.z); z[5] = bf_hi(ya.z); z[6] = bf_lo(ya.w); z[7] = bf_hi(ya.w);
        float sy = 0.f, sz = 0.f;
#pragma unroll
        for (int e = 0; e < 8; ++e) { sy += y[e] * y[e]; sz += z[e] * z[e]; }
        sy = wave_sum(sy); sz = wave_sum(sz);
        const float ry = __builtin_amdgcn_rsqf(sy * (1.0f / 512.0f) + EPS), rz = __builtin_amdgcn_rsqf(sz * (1.0f / 512.0f) + EPS);
        u32x4 wy, wz;
        wy.x = pk_bf16(y[0] * ry * gr0[0], y[1] * ry * gr0[1]); wy.y = pk_bf16(y[2] * ry * gr0[2], y[3] * ry * gr0[3]); wy.z = pk_bf16(y[4] * ry * gr1[0], y[5] * ry * gr1[1]); wy.w = pk_bf16(y[6] * ry * gr1[2], y[7] * ry * gr1[3]);
        wz.x = pk_bf16(z[0] * rz * ga0[0], z[1] * rz * ga0[1]); wz.y = pk_bf16(z[2] * rz * ga0[2], z[3] * rz * ga0[3]); wz.z = pk_bf16(z[4] * rz * ga1[0], z[5] * rz * ga1[1]); wz.w = pk_bf16(z[6] * rz * ga1[2], z[7] * rz * ga1[3]);
        *(u32x4*)(Y + row * DM + 8 * lane) = wy; *(u32x4*)(Y + row * DM + 512 + 8 * lane) = wz;
    }
    __syncthreads();
}

__global__ void __launch_bounds__(NTHR, 2) fwd_megakernel(Args a) {
    extern __shared__ __attribute__((aligned(16))) unsigned char lds[];
    cg::grid_group grid = cg::this_grid();
    const int tid = threadIdx.x, lane = tid & 63, wave = __builtin_amdgcn_readfirstlane(tid >> 6);
    const int G = gridDim.x, bx = blockIdx.x;
    const int gw = bx * NWAVES + wave, NGW = G * NWAVES;
    unsigned char* ws = a.ws;
    PG8_LAS unsigned char* glds = (PG8_LAS unsigned char*)lds;
    const int lo = a.ph_lo, hi = a.ph_hi;
#define IN(k) (lo <= (k) && (k) < hi)
#define SEAM(k) do { if (IN(k) && IN((k) + 1)) grid.sync(); } while (0)
    bf16_t* XB = (bf16_t*)(ws + WS_XB); float* SSQ0 = (float*)(ws + WS_SSQ); float* SSQ1 = SSQ0 + (size_t)T * 16; float* SSQ2 = SSQ1 + (size_t)T * 16;
    bf16_t* ACT = (bf16_t*)(ws + WS_ACT);

    if (IN(0)) { phase_prologue(a, lds, gw, NGW, wave, lane); SEAM(0); }
    if (IN(1)) {
        pg8::Gemm g{XB, (const bf16_t*)(ws + WS_WGU1), T, 2 * DFF, DM}; pg8::StaticOrder S; S.init(T, 2 * DFF, G, bx);
        pg8::EpiSwiGLU E{ACT, DFF, SSQ0};
        pg8::gemm_phase<pg8::EpiSwiGLU, pg8::StaticOrder, true, true>(glds, g, S, E); SEAM(1); }
    if (IN(2)) {
        pg8::Gemm g{ACT, (const bf16_t*)(ws + WS_WD1), T, DM, DFF}; pg8::StaticOrder S; S.init(T, DM, G, bx);
        pg8::EpiResid E{a.in[I_X], a.out, XB, SSQ1, 0.5f};
        pg8::gemm_phase<pg8::EpiResid, pg8::StaticOrder, true, true>(glds, g, S, E); SEAM(2); }
    if (IN(3)) {
        pg8::Gemm g{XB, (const bf16_t*)(ws + WS_WIN), T, NIN, DM}; pg8::StaticOrder S; S.init(T, NIN, G, bx);
        pg8::EpiInProj E{(bf16_t*)(ws + WS_PROJ), SSQ1, a.in[I_QN], a.in[I_KN]};
        pg8::gemm_phase<pg8::EpiInProj, pg8::StaticOrder, true, true>(glds, g, S, E); SEAM(3); }
    if (IN(4)) {
        for (int it = gw; it < 2048; it += NGW) rnn_item(a, it, (float*)(lds + wave * 16384), lane);
        for (int it = gw; it < 2048; it += NGW) attn_item(a, it, lane);
        SEAM(4); }
    if (IN(5)) { for (int u = bx; u < 4 * NCHUNK; u += G) finalize_unit(a, u, (float*)lds, tid, wave, lane); SEAM(5); }
    if (IN(6)) {
        pg8::Gemm g{(const bf16_t*)(ws + WS_Y), (const bf16_t*)(ws + WS_WOUT), T, DM, DM}; pg8::StaticOrder S; S.init(T, DM, G, bx);
        pg8::EpiResid E{a.out, a.out, XB, SSQ2, 1.0f};
        pg8::gemm_phase<pg8::EpiResid, pg8::StaticOrder, true, true>(glds, g, S, E); SEAM(6); }
    if (IN(7)) {
        pg8::Gemm g{XB, (const bf16_t*)(ws + WS_WGU2), T, 2 * DFF, DM}; pg8::StaticOrder S; S.init(T, 2 * DFF, G, bx);
        pg8::EpiSwiGLU E{ACT, DFF, SSQ2};
        pg8::gemm_phase<pg8::EpiSwiGLU, pg8::StaticOrder, true, true>(glds, g, S, E); SEAM(7); }
    if (IN(8)) {
        pg8::Gemm g{ACT, (const bf16_t*)(ws + WS_WD2), T, DM, DFF}; pg8::StaticOrder S; S.init(T, DM, G, bx);
        pg8::EpiResid E{a.out, a.out, nullptr, nullptr, 0.5f};
        pg8::gemm_phase<pg8::EpiResid, pg8::StaticOrder, true, true>(glds, g, S, E); }
#undef IN
#undef SEAM
}

extern "C" void kernel_launch(void* const* d_in, const int* in_sizes, int n_in, void* d_out, int out_size, void* d_ws, size_t ws_size, hipStream_t stream) {
    static int grid = 0;
    if (grid == 0) {
        if (n_in != 23 || in_sizes[0] != T * DM || out_size != T * DM || ws_size < WS_END) { fprintf(stderr, "kernel_launch: unexpected shapes (n_in %d, in0 %d, out %d, ws %zu)\n", n_in, n_in > 0 ? in_sizes[0] : -1, out_size, ws_size); grid = -1; return; }
        int dev = 0, cus = 0, per_cu = 0;
        hipGetDevice(&dev); hipDeviceGetAttribute(&cus, hipDeviceAttributeMultiprocessorCount, dev);
        if (hipFuncSetAttribute((const void*)fwd_megakernel, hipFuncAttributeMaxDynamicSharedMemorySize, LDS_BYTES) != hipSuccess) { fprintf(stderr, "kernel_launch: hipFuncSetAttribute failed\n"); grid = -1; return; }
        if (hipOccupancyMaxActiveBlocksPerMultiprocessor(&per_cu, (const void*)fwd_megakernel, NTHR, LDS_BYTES) != hipSuccess || per_cu < 1) { fprintf(stderr, "kernel_launch: occupancy query says %d\n", per_cu); per_cu = 1; }
        (void)hipGetLastError();
        grid = cus * 1;
        if (grid <= 0) grid = 256;
    }
    if (grid < 0) return;
    Args a{};
    for (int i = 0; i < 23; ++i) a.in[i] = (const float*)d_in[i];
    a.out = (float*)d_out; a.ws = (unsigned char*)d_ws;
#if MK_LAUNCHES == 1
    a.ph_lo = 0; a.ph_hi = N_PHASES;
    void* args[] = {&a};
    hipError_t e = hipLaunchCooperativeKernel((const void*)fwd_megakernel, dim3(grid), dim3(NTHR), args, LDS_BYTES, stream);
    if (e != hipSuccess) fprintf(stderr, "kernel_launch: cooperative launch failed: %s (grid %d)\n", hipGetErrorString(e), grid);
#else
    for (int p = 0; p < N_PHASES; ++p) { a.ph_lo = p; a.ph_hi = p + 1; hipLaunchKernelGGL(fwd_megakernel, dim3(grid), dim3(NTHR), LDS_BYTES, stream, a); }
#endif
}
```

```cpp
#include <hip/hip_runtime.h>
#include <cstdio>
#include <cstdint>
namespace pg8 {
#define PG8_LAS __attribute__((address_space(3)))
typedef unsigned short bf16_t;
typedef short bf16x8 __attribute__((ext_vector_type(8)));
typedef float f32x4 __attribute__((ext_vector_type(4)));
typedef unsigned u32x4 __attribute__((ext_vector_type(4)));
constexpr int BM = 256, BK = 64, HALF = 128, HTB = HALF * BK * 2  , STAGE_BYTES = 8 * HTB, NXCD = 8, WGM = 8;

__host__ __device__ __forceinline__ int lds_byte(int r, int c) { const int st = (r >> 4) * 2 + (c >> 5), rr = r & 15, cc = c & 31, ob = rr * 64 + cc * 2; return st * 1024 + (ob ^ (((ob >> 9) & 1) << 5)); }
__host__ __device__ __forceinline__ void stage_rc(int b, int& R, int& C) { const int st = b / 1024, sb = b % 1024, swz = sb ^ (((sb >> 9) & 1) << 5); R = (st >> 1) * 16 + swz / 64; C = (st & 1) * 32 + (swz % 64) / 2; }
__host__ __device__ __forceinline__ int perm32(int rho) { const int n = rho >> 4, i = rho & 15; return 8 * (i >> 2) + 4 * n + (i & 3); }

struct Unit { int pm, pn; };
struct Gemm { const bf16_t* A; const bf16_t* Bt; int M, N, K; };

struct StaticOrder {
    int nM, nN, nwg, G, c;
    __host__ __device__ void init(int M, int N, int G_, int c_) { nM = M / BM; nN = N / BM; nwg = nM * nN; G = G_; c = c_; }
    __host__ __device__ bool next(int i, Unit& u) const {
        const long L = (long)i * G + c; if (L >= nwg) return false;
        int wgid = (int)L; { const int q = nwg / NXCD, r = nwg % NXCD, xcd = wgid % NXCD, off = wgid / NXCD; wgid = (xcd < r ? xcd * (q + 1) : r * (q + 1) + (xcd - r) * q) + off; }
        const int nig = WGM * nN, gid = wgid / nig, fm = gid * WGM, gsz = (nM - fm) < WGM ? (nM - fm) : WGM;
        u.pm = fm + ((wgid % nig) % gsz); u.pn = (wgid % nig) / gsz; return true;
    }
    __device__ __forceinline__ void a_ready(const Unit&) const {}
    __device__ __forceinline__ void done(const Unit&) const {}
};

__device__ __forceinline__ unsigned cvt_pk_bf16(float lo, float hi) { unsigned r; asm volatile("v_cvt_pk_bf16_f32 %0, %1, %2" : "=v"(r) : "v"(lo), "v"(hi)); return r; }
typedef float f32x2 __attribute__((ext_vector_type(2)));

__device__ __forceinline__ float row_rs(const float* ssq, int row, int fq, float inv_n, float eps) {
    const f32x4 a = *(const f32x4*)(ssq + (size_t)row * 16 + 4 * fq);
    float s = (a[0] + a[1]) + (a[2] + a[3]);
    s += __shfl_xor(s, 16); s += __shfl_xor(s, 32);
    return __builtin_amdgcn_rsqf(s * inv_n + eps);
}
__device__ __forceinline__ float silu_mul(float g, float up) { return g * __builtin_amdgcn_rcpf(1.0f + __builtin_amdgcn_exp2f(-1.4426950408889634f * g)) * up; }

struct EpiSwiGLU {
    static constexpr bool PERM = true, AFTER_DRAIN = false;
    bf16_t* O; int ldc; const float* ssq; const float* rsl; int pm_c;
    __device__ __forceinline__ void operator()(const f32x4 (&acc)[2][2][4][2], const Unit& u, int wr, int wc, int fr, int fq) const {
        const int row0 = u.pm * BM + wr * 64 + fr, col0 = u.pn * HALF + wc * 32 + 8 * fq;
        float rsv[2][4];
        if (u.pm == pm_c) {
#pragma unroll
            for (int ai = 0; ai < 2; ++ai)
#pragma unroll
                for (int m = 0; m < 4; ++m) rsv[ai][m] = rsl[ai * HALF + wr * 64 + m * 16 + fr];
        } else {
            asm volatile("" ::: "memory");
#pragma unroll
            for (int ai = 0; ai < 2; ++ai)
#pragma unroll
                for (int m = 0; m < 4; ++m) rsv[ai][m] = row_rs(ssq, row0 + ai * HALF + m * 16, fq, 1.0f / 1024.0f, 1e-6f);
        }
#pragma unroll
        for (int ai = 0; ai < 2; ++ai)
#pragma unroll
            for (int m = 0; m < 4; ++m) {
                const int row = row0 + ai * HALF + m * 16;
                const float rs = rsv[ai][m];
                float o[8];
#pragma unroll
                for (int n = 0; n < 2; ++n)
#pragma unroll
                    for (int e = 0; e < 4; ++e) o[n * 4 + e] = silu_mul(acc[ai][0][m][n][e] * rs, acc[ai][1][m][n][e] * rs);
                u32x4 w; w.x = cvt_pk_bf16(o[0], o[1]); w.y = cvt_pk_bf16(o[2], o[3]); w.z = cvt_pk_bf16(o[4], o[5]); w.w = cvt_pk_bf16(o[6], o[7]);
                *(u32x4*)(O + (size_t)row * ldc + col0) = w;
            }
    }
};

struct EpiResid {
    static constexpr bool PERM = true, AFTER_DRAIN = false;
    const bf16_t* rb; float* outf; bf16_t* xb; float* ssq_out; float alpha;
    __device__ __forceinline__ void operator()(const f32x4 (&acc)[2][2][4][2], const Unit& u, int wr, int wc, int fr, int fq) const {
        const int row0 = u.pm * BM + wr * 64 + fr, col0 = u.pn * BM + wc * 32 + 8 * fq;
        u32x4 rv[2][4][2];
#pragma unroll
        for (int ai = 0; ai < 2; ++ai)
#pragma unroll
            for (int m = 0; m < 4; ++m)
#pragma unroll
                for (int bj = 0; bj < 2; ++bj) rv[ai][m][bj] = *(const u32x4*)(rb + (size_t)(row0 + ai * HALF + m * 16) * 1024 + col0 + bj * HALF);
#pragma unroll
        for (int ai = 0; ai < 2; ++ai)
#pragma unroll
            for (int m = 0; m < 4; ++m) {
                const int row = row0 + ai * HALF + m * 16; float s = 0.f;
#pragma unroll
                for (int bj = 0; bj < 2; ++bj) {
                    const size_t off = (size_t)row * 1024 + col0 + bj * HALF; const u32x4 r = rv[ai][m][bj];
                    const f32x4 r0 = {__uint_as_float(r.x << 16), __uint_as_float(r.x & 0xffff0000u), __uint_as_float(r.y << 16), __uint_as_float(r.y & 0xffff0000u)};
                    const f32x4 r1 = {__uint_as_float(r.z << 16), __uint_as_float(r.z & 0xffff0000u), __uint_as_float(r.w << 16), __uint_as_float(r.w & 0xffff0000u)};
                    const f32x4 v0 = r0 + acc[ai][bj][m][0] * alpha, v1 = r1 + acc[ai][bj][m][1] * alpha;
                    if (outf) { __builtin_nontemporal_store(v0, (f32x4*)(outf + off)); __builtin_nontemporal_store(v1, (f32x4*)(outf + off + 4)); }
                    if (xb) { u32x4 w; w.x = cvt_pk_bf16(v0[0], v0[1]); w.y = cvt_pk_bf16(v0[2], v0[3]); w.z = cvt_pk_bf16(v1[0], v1[1]); w.w = cvt_pk_bf16(v1[2], v1[3]); *(u32x4*)(xb + off) = w; }
                    s += ((v0[0] * v0[0] + v0[1] * v0[1]) + (v0[2] * v0[2] + v0[3] * v0[3])) + ((v1[0] * v1[0] + v1[1] * v1[1]) + (v1[2] * v1[2] + v1[3] * v1[3]));
                }
                if (ssq_out) { s += __shfl_xor(s, 16); s += __shfl_xor(s, 32); if (fq == 0) ssq_out[(size_t)row * 16 + u.pn * 4 + wc] = s; }
            }
    }
};

struct EpiInProj {
    static constexpr bool PERM = true, AFTER_DRAIN = false;
    bf16_t* O; const float* ssq; const float* qn; const float* kn; const float* rsl; int pm_c;
    __device__ __forceinline__ void operator()(const f32x4 (&acc)[2][2][4][2], const Unit& u, int wr, int wc, int fr, int fq) const {
        const int row0 = u.pm * BM + wr * 64 + fr, col0 = u.pn * BM + wc * 64 + 8 * fq;
        const bool isq = (u.pn == 4 || u.pn == 5), isk = (u.pn == 6 || u.pn == 7), hn = isq || isk;
        f32x4 gn[2][2];
#pragma unroll
        for (int bj = 0; bj < 2; ++bj)
#pragma unroll
            for (int n = 0; n < 2; ++n) { gn[bj][n] = (f32x4){1.f, 1.f, 1.f, 1.f}; if (hn) gn[bj][n] = *(const f32x4*)((isq ? qn : kn) + 32 * bj + 8 * fq + 4 * n) * (isq ? 0.125f : 1.0f); }
        float rsv[2][4];
        if (u.pm == pm_c) {
#pragma unroll
            for (int ai = 0; ai < 2; ++ai)
#pragma unroll
                for (int m = 0; m < 4; ++m) rsv[ai][m] = rsl[ai * HALF + wr * 64 + m * 16 + fr];
        } else {
            asm volatile("" ::: "memory");
#pragma unroll
            for (int ai = 0; ai < 2; ++ai)
#pragma unroll
                for (int m = 0; m < 4; ++m) rsv[ai][m] = row_rs(ssq, row0 + ai * HALF + m * 16, fq, 1.0f / 1024.0f, 1e-6f);
        }
#pragma unroll
        for (int ai = 0; ai < 2; ++ai)
#pragma unroll
            for (int m = 0; m < 4; ++m) {
                const int row = row0 + ai * HALF + m * 16;
                const float rs = rsv[ai][m];
                f32x4 v[2][2]; float s = 0.f;
#pragma unroll
                for (int bj = 0; bj < 2; ++bj)
#pragma unroll
                    for (int n = 0; n < 2; ++n) { v[bj][n] = acc[ai][bj][m][n] * rs; const f32x4 t = v[bj][n]; s += (t[0] * t[0] + t[1] * t[1]) + (t[2] * t[2] + t[3] * t[3]); }
                if (hn) { s += __shfl_xor(s, 16); s += __shfl_xor(s, 32); const float rq = __builtin_amdgcn_rsqf(s * (1.0f / 64.0f) + 1e-6f);
#pragma unroll
                    for (int bj = 0; bj < 2; ++bj)
#pragma unroll
                        for (int n = 0; n < 2; ++n) v[bj][n] = v[bj][n] * rq * gn[bj][n]; }
#pragma unroll
                for (int bj = 0; bj < 2; ++bj) { u32x4 w; w.x = cvt_pk_bf16(v[bj][0][0], v[bj][0][1]); w.y = cvt_pk_bf16(v[bj][0][2], v[bj][0][3]); w.z = cvt_pk_bf16(v[bj][1][0], v[bj][1][1]); w.w = cvt_pk_bf16(v[bj][1][2], v[bj][1][3]);
                    *(u32x4*)(O + (size_t)row * 2560 + col0 + 32 * bj) = w; }
            }
    }
};

template <class Epi, class Sched, bool ALIGN_EPI = false, bool SP2 = false>
__device__ __forceinline__ void gemm_phase(PG8_LAS unsigned char* lds, const Gemm g, const Sched& S, const Epi& E) {
    const int tid = threadIdx.x, wid = __builtin_amdgcn_readfirstlane(tid >> 6), lane = tid & 63, wr = wid >> 2, wc = wid & 3, fr = lane & 15, fq = lane >> 4;
    const int K = g.K, nt = K / BK;
    unsigned voffA[2], voffB[2];
#pragma unroll
    for (int i = 0; i < 2; ++i) { int R, C; stage_rc(tid * 16 + i * 8192, R, C); const int Rb = Epi::PERM ? ((R & ~31) + perm32(R & 31)) : R;
        voffA[i] = (unsigned)(R * K + C) * 2u; voffB[i] = (unsigned)(Rb * K + C) * 2u; }
    const size_t kstep = (size_t)(BK * 2);
    const size_t hstep = (size_t)HALF * K * 2;
    const size_t tstep = 2 * hstep;
    const unsigned ldsw = (unsigned)wid * 1024u;
    const int aoff = lds_byte(wr * 64 + fr, fq * 8), boff = lds_byte(wc * 32 + fr, fq * 8);
#define PG8_SA(b, h) (((b) * 2 + (h)) * HTB)
#define PG8_SB(b, h) ((4 + (b) * 2 + (h)) * HTB)
#define PG8_STAGE(bufoff, gbase, voff) do { _Pragma("unroll") for (int _i = 0; _i < 2; ++_i) \
        __builtin_amdgcn_global_load_lds((const unsigned*)((const char*)(gbase) + (voff)[_i]), (PG8_LAS unsigned*)(lds + (bufoff) + ldsw + _i * 8192), 16, 0, 0); } while (0)
#define PG8_LDA(dst, b, h) do { _Pragma("unroll") for (int m = 0; m < 4; ++m) _Pragma("unroll") for (int k = 0; k < 2; ++k) dst[m][k] = *(const PG8_LAS bf16x8*)(lds + PG8_SA(b, h) + aoff + m * 2048 + k * 1024); } while (0)
#define PG8_LDB(dst, b, h) do { _Pragma("unroll") for (int n = 0; n < 2; ++n) _Pragma("unroll") for (int k = 0; k < 2; ++k) dst[n][k] = *(const PG8_LAS bf16x8*)(lds + PG8_SB(b, h) + boff + n * 2048 + k * 1024); } while (0)
#define PG8_MMA(ai, bj, At, Bt) do { __builtin_amdgcn_s_setprio(1); _Pragma("unroll") for (int m = 0; m < 4; ++m) _Pragma("unroll") for (int n = 0; n < 2; ++n) _Pragma("unroll") for (int k = 0; k < 2; ++k) \
        acc[ai][bj][m][n] = __builtin_amdgcn_mfma_f32_16x16x32_bf16(Bt[n][k], At[m][k], acc[ai][bj][m][n], 0, 0, 0); __builtin_amdgcn_s_setprio(0); } while (0)
#define PG8_WAIT_V(n) asm volatile("s_waitcnt vmcnt(" #n ")" ::: "memory")
#define PG8_WAIT_L(n) asm volatile("s_waitcnt lgkmcnt(" #n ")" ::: "memory")
#define PG8_BAR __builtin_amdgcn_s_barrier()
#define PG8_SCHED __builtin_amdgcn_sched_barrier(0)
    Unit cur, nxt; int ui = 0;
    if (!S.next(0, cur)) return;
    f32x4 acc[2][2][4][2];
#pragma unroll
    for (int a = 0; a < 2; ++a)
#pragma unroll
        for (int b = 0; b < 2; ++b)
#pragma unroll
            for (int m = 0; m < 4; ++m)
#pragma unroll
                for (int n = 0; n < 2; ++n) acc[a][b][m][n] = (f32x4){0.f, 0.f, 0.f, 0.f};
    bf16x8 At[4][2], B0[2][2], B1[2][2];
    const char* cA = (const char*)g.A + (size_t)cur.pm * tstep; const char* cB = (const char*)g.Bt + (size_t)cur.pn * tstep;
    S.a_ready(cur);
    if constexpr (SP2) {
        PG8_STAGE(PG8_SB(0, 0), cB, voffB); PG8_STAGE(PG8_SB(0, 1), cB + hstep, voffB); PG8_STAGE(PG8_SA(0, 0), cA, voffA); PG8_STAGE(PG8_SA(0, 1), cA + hstep, voffA);
        if (wr == 1) PG8_BAR;
        PG8_WAIT_V(2); PG8_BAR;
        PG8_STAGE(PG8_SB(1, 0), cB + kstep, voffB); PG8_STAGE(PG8_SA(1, 0), cA + kstep, voffA); PG8_STAGE(PG8_SB(1, 1), cB + hstep + kstep, voffB);
        PG8_WAIT_V(6); PG8_BAR;
    } else {
        PG8_STAGE(PG8_SB(0, 0), cB, voffB); PG8_STAGE(PG8_SA(0, 0), cA, voffA); PG8_STAGE(PG8_SB(0, 1), cB + hstep, voffB); PG8_STAGE(PG8_SA(0, 1), cA + hstep, voffA);
        if (wr == 1) PG8_BAR;
        PG8_WAIT_V(4); PG8_BAR;
        PG8_STAGE(PG8_SB(1, 0), cB + kstep, voffB); PG8_STAGE(PG8_SA(1, 0), cA + kstep, voffA); PG8_STAGE(PG8_SB(1, 1), cB + hstep + kstep, voffB);
        PG8_WAIT_V(6); PG8_BAR;
    }
    for (;;) {
        const bool has_next = S.next(ui + 1, nxt);
        const char* nA = has_next ? (const char*)g.A + (size_t)nxt.pm * tstep : cA; const char* nB = has_next ? (const char*)g.Bt + (size_t)nxt.pn * tstep : cB;
        for (int t = 0; t < nt; t += 2) {
            const bool last = (t == nt - 2);
            const char* a1 = cA + (size_t)(t + 1) * kstep;
            const char* a2 = last ? nA : cA + (size_t)(t + 2) * kstep; const char* b2 = last ? nB : cB + (size_t)(t + 2) * kstep;
            const char* a3 = a2 + kstep; const char* b3 = b2 + kstep;
            if (last && has_next) S.a_ready(nxt);
            if constexpr (SP2) {
            PG8_LDB(B0, 0, 0); PG8_LDB(B1, 0, 1); PG8_SCHED; PG8_LDA(At, 0, 0); PG8_STAGE(PG8_SA(1, 1), a1 + hstep, voffA);
            PG8_WAIT_V(8); PG8_WAIT_L(0); PG8_BAR; PG8_MMA(0, 0, At, B0); PG8_MMA(0, 1, At, B1); PG8_BAR; PG8_SCHED;
            PG8_LDA(At, 0, 1); PG8_STAGE(PG8_SB(0, 0), b2, voffB); PG8_STAGE(PG8_SB(0, 1), b2 + hstep, voffB); PG8_STAGE(PG8_SA(0, 0), a2, voffA);
            PG8_WAIT_V(8); PG8_WAIT_L(0); PG8_BAR; PG8_MMA(1, 0, At, B0); PG8_MMA(1, 1, At, B1); PG8_BAR; PG8_SCHED;
            PG8_LDB(B0, 1, 0); PG8_LDB(B1, 1, 1); PG8_SCHED; PG8_LDA(At, 1, 0); PG8_STAGE(PG8_SA(0, 1), a2 + hstep, voffA);
            PG8_WAIT_V(8); PG8_WAIT_L(0); PG8_BAR; PG8_MMA(0, 0, At, B0); PG8_MMA(0, 1, At, B1); PG8_BAR; PG8_SCHED;
            PG8_LDA(At, 1, 1); PG8_STAGE(PG8_SB(1, 0), b3, voffB); PG8_STAGE(PG8_SB(1, 1), b3 + hstep, voffB); PG8_STAGE(PG8_SA(1, 0), a3, voffA);
            PG8_WAIT_V(8); PG8_WAIT_L(0); PG8_BAR; PG8_MMA(1, 0, At, B0); PG8_MMA(1, 1, At, B1); PG8_BAR; PG8_SCHED;
            } else {
            PG8_LDB(B0, 0, 0); PG8_SCHED; PG8_LDA(At, 0, 0); PG8_STAGE(PG8_SA(1, 1), a1 + hstep, voffA);
            PG8_WAIT_L(8); PG8_BAR; PG8_WAIT_L(0); PG8_MMA(0, 0, At, B0); PG8_BAR; PG8_SCHED;
            PG8_LDB(B1, 0, 1); PG8_STAGE(PG8_SB(0, 0), b2, voffB);
            PG8_BAR; PG8_WAIT_L(0); PG8_MMA(0, 1, At, B1); PG8_BAR;
            PG8_LDA(At, 0, 1); PG8_STAGE(PG8_SA(0, 0), a2, voffA);
            PG8_BAR; PG8_WAIT_L(0); PG8_MMA(1, 0, At, B0); PG8_BAR; PG8_SCHED;
            PG8_STAGE(PG8_SB(0, 1), b2 + hstep, voffB);
            PG8_WAIT_V(6); PG8_BAR; PG8_MMA(1, 1, At, B1); PG8_BAR;
            PG8_LDB(B0, 1, 0); PG8_SCHED; PG8_LDA(At, 1, 0); PG8_STAGE(PG8_SA(0, 1), a2 + hstep, voffA);
            PG8_WAIT_L(8); PG8_BAR; PG8_WAIT_L(0); PG8_MMA(0, 0, At, B0); PG8_BAR; PG8_SCHED;
            PG8_LDB(B1, 1, 1); PG8_STAGE(PG8_SB(1, 0), b3, voffB);
            PG8_BAR; PG8_WAIT_L(0); PG8_MMA(0, 1, At, B1); PG8_BAR;
            PG8_LDA(At, 1, 1); PG8_STAGE(PG8_SA(1, 0), a3, voffA);
            PG8_BAR; PG8_WAIT_L(0); PG8_MMA(1, 0, At, B0); PG8_BAR; PG8_SCHED;
            PG8_STAGE(PG8_SB(1, 1), b3 + hstep, voffB);
            PG8_WAIT_V(6); PG8_BAR; PG8_MMA(1, 1, At, B1); PG8_BAR;
            }
        }
        if constexpr (ALIGN_EPI) { if (wr == 0) PG8_BAR; }
        if constexpr (!Epi::AFTER_DRAIN) { E(acc, cur, wr, wc, fr, fq); S.done(cur); }
        if (!has_next) break;
#pragma unroll
        for (int a = 0; a < 2; ++a)
#pragma unroll
            for (int b = 0; b < 2; ++b)
#pragma unroll
                for (int m = 0; m < 4; ++m)
#pragma unroll
                    for (int n = 0; n < 2; ++n) acc[a][b][m][n] = (f32x4){0.f, 0.f, 0.f, 0.f};
        cur = nxt; cA = nA; cB = nB; ++ui;
        if constexpr (ALIGN_EPI) { if (wr == 1) PG8_BAR; }
    }
    PG8_WAIT_V(0);
    if constexpr (!ALIGN_EPI) { if (wr == 0) PG8_BAR; }
    PG8_BAR;
    if constexpr (Epi::AFTER_DRAIN) { E.fused(acc, cur, wr, wc, fr, fq, lds, wid, lane); S.done(cur); }
#undef PG8_SA
#undef PG8_SB
#undef PG8_STAGE
#undef PG8_LDA
#undef PG8_LDB
#undef PG8_MMA
#undef PG8_WAIT_V
#undef PG8_WAIT_L
#undef PG8_BAR
#undef PG8_SCHED
}
}

#include <hip/hip_cooperative_groups.h>
namespace cg = cooperative_groups;
#ifndef DOUBLE_PHASE
#define DOUBLE_PHASE (-1)
#endif
#define REP(k) for (int rep_ = 0; rep_ < ((DOUBLE_PHASE) == (k) ? 2 : 1); ++rep_)
#ifndef MK_LAUNCHES
#define MK_LAUNCHES 1
#endif
typedef unsigned short bf16_t;
typedef float f32x4 __attribute__((ext_vector_type(4)));
typedef unsigned u32x4 __attribute__((ext_vector_type(4)));
typedef unsigned u32x2 __attribute__((ext_vector_type(2)));
constexpr int NWAVES = 8, NTHR = 512, N_PHASES = 9;
constexpr int T = 16384, SEQ = 4096, DM = 1024, DFF = 2816, NIN = 2560, DRNN = 512, NCHUNK = 64;
constexpr float EPS = 1e-6f;
constexpr size_t MiB = 1u << 20;
constexpr size_t WS_WIN = 0, WS_WOUT = 5 * MiB, WS_WGU2 = 7 * MiB, WS_WD2 = 18 * MiB, WS_SSQ = 24 * MiB, WS_SUM = 27 * MiB, WS_XB = 28 * MiB;
constexpr size_t WS_WGU1 = 60 * MiB, WS_WD1 = 71 * MiB, WS_ACT = 77 * MiB;
constexpr size_t WS_PROJ = 60 * MiB, WS_H = 140 * MiB, WS_P = 172 * MiB, WS_Y = 204 * MiB, WS_BAR = 236 * MiB, WS_END = 237 * MiB;
constexpr size_t WS_WPK = WS_BAR + 512 * 1024;
constexpr size_t WS_GRAN = 237 * MiB, WS_END2 = 239 * MiB;
constexpr size_t BAR_ZERO_BYTES = 16384;
static_assert(WS_WD2 + (size_t)DM * DFF * 2 <= WS_SSQ && WS_ACT + (size_t)T * DFF * 2 <= WS_Y && WS_PROJ + (size_t)T * NIN * 2 <= WS_H, "d_ws map");
constexpr int LDS_CTL_OFF = 131072, LDS_RS_OFF = 131072 + 256, LDS_BYTES = 131072 + 256 + 1024;

__device__ __forceinline__ float bf_lo(unsigned u) { return __uint_as_float(u << 16); }
__device__ __forceinline__ float bf_hi(unsigned u) { return __uint_as_float(u & 0xffff0000u); }
__device__ __forceinline__ float bf_1(bf16_t u) { return __uint_as_float((unsigned)u << 16); }
__device__ __forceinline__ unsigned pk_bf16(float lo, float hi) { return pg8::cvt_pk_bf16(lo, hi); }
__device__ __forceinline__ float wave_sum(float v) {
#pragma unroll
    for (int o = 1; o < 64; o <<= 1) v += __shfl_xor(v, o);
    return v;
}
__device__ __forceinline__ float gelu_tanh(float x) {
    const float u = 0.7978845608028654f * (x + 0.044715f * x * x * x);
    const float t = 1.0f - 2.0f * __builtin_amdgcn_rcpf(1.0f + __builtin_amdgcn_exp2f(2.0f * 1.4426950408889634f * u));
    return 0.5f * x * (1.0f + t);
}

#define GAS __attribute__((address_space(1)))
#define LAS __attribute__((address_space(3)))
typedef GAS unsigned gu32;
typedef GAS unsigned long long gu64;
#define RLX_AGENT __ATOMIC_RELAXED, __HIP_MEMORY_SCOPE_AGENT
#define LDS_WAIT() asm volatile("s_waitcnt lgkmcnt(0)" ::: "memory")
#define VM_WAIT() asm volatile("s_waitcnt vmcnt(0)" ::: "memory")
__device__ __forceinline__ unsigned long long rt() { return __builtin_amdgcn_s_memrealtime(); }
#define XB_TMO      128
#define XB_XCNT(j)  (256  + 64 * (j))
#define XB_XSUB(j)  (1280 + 64 * (j))
#define XB_XGEN(j)  (2304 + 64 * (j))
#define XB_TOP      3328
#define XB_TOPGEN   3392
#define XCD_BAR_WORDS 3456
#define XB_SPIN_CAP (1u << 18)

__device__ __forceinline__ unsigned xb_ld(unsigned* p)              { return __hip_atomic_load(p, __ATOMIC_RELAXED, __HIP_MEMORY_SCOPE_AGENT); }
__device__ __forceinline__ unsigned xb_add(unsigned* p, unsigned v) { return __hip_atomic_fetch_add(p, v, __ATOMIC_RELAXED, __HIP_MEMORY_SCOPE_AGENT); }
__device__ __forceinline__ unsigned xb_xcc_id() { return (unsigned)__builtin_amdgcn_s_getreg((3 << 11) | 20) & 0xFu; }
#define XB_SPIN(cond, bar) do { unsigned _sp = 0; while (cond) { __builtin_amdgcn_s_sleep(1); \
    if ((++_sp & 255u) == 0u) { if (xb_ld(&(bar)[XB_TMO])) break; if (_sp > XB_SPIN_CAP) { atomicAdd(&(bar)[XB_TMO], 1u); break; } } } } while (0)

struct XcdBarrier {
    unsigned* bar; unsigned x;
    volatile LAS unsigned* st;
};

__device__ __forceinline__ XcdBarrier xcd_barrier_post(unsigned* bar, volatile LAS unsigned* st) {
    XcdBarrier b; b.bar = bar; b.x = xb_xcc_id(); b.st = st;
    if (threadIdx.x == 0) (void)xb_add(&bar[XB_XCNT(b.x)], 1u);
    return b;
}
__device__ __forceinline__ void xcd_barrier_complete(unsigned* bar, unsigned x, unsigned& nloc, unsigned& nx) {
    const unsigned G = gridDim.x * gridDim.y * gridDim.z;
    unsigned sum, cnt, mine, sp = 0u;
    for (;;) {
        sum = 0u; cnt = 0u; mine = 0u;
#pragma unroll
        for (unsigned j = 0; j < 16; ++j) { const unsigned c = xb_ld(&bar[XB_XCNT(j)]); sum += c; cnt += (c > 0u) ? 1u : 0u; mine = (j == x) ? c : mine; }
        if (sum == G) break;
        __builtin_amdgcn_s_sleep(1);
        if ((++sp & 255u) == 0u) { if (xb_ld(&bar[XB_TMO])) break; if (sp > XB_SPIN_CAP) { atomicAdd(&bar[XB_TMO], 1u); break; } }
    }
    nloc = mine > 0u ? mine : 1u; nx = cnt > 0u ? cnt : 1u;
}

__device__ __forceinline__ void xcd_barrier(const XcdBarrier& b) {
    asm volatile("s_waitcnt vmcnt(0)" ::: "memory");
    __syncthreads();
    if (threadIdx.x == 0) {
        unsigned* bar = b.bar;
        __builtin_amdgcn_s_waitcnt(0);
        unsigned nloc = b.st[0], nx = b.st[1];
        if (nloc == 0u) { xcd_barrier_complete(bar, b.x, nloc, nx); b.st[0] = nloc; b.st[1] = nx; }
        const unsigned old = xb_add(&bar[XB_XSUB(b.x)], 1u);
        const unsigned gen = old / nloc;
        if (old + 1u == (gen + 1u) * nloc) {
            __builtin_amdgcn_fence(__ATOMIC_RELEASE, "agent");
            asm volatile("s_waitcnt vmcnt(0)" ::: "memory");
            const unsigned og = xb_add(&bar[XB_TOP], 1u);
            const unsigned tg = og / nx;
            if (og + 1u == (tg + 1u) * nx) xb_add(&bar[XB_TOPGEN], 1u);
            else XB_SPIN(xb_ld(&bar[XB_TOPGEN]) == tg, bar);
            __builtin_amdgcn_fence(__ATOMIC_ACQUIRE, "agent");
            xb_add(&bar[XB_XGEN(b.x)], 1u);
            asm volatile("s_waitcnt vmcnt(0)" ::: "memory");
        } else {
            XB_SPIN(xb_ld(&bar[XB_XGEN(b.x)]) == gen, bar);
            __builtin_amdgcn_fence(__ATOMIC_ACQUIRE, "agent");
            asm volatile("s_waitcnt vmcnt(0)" ::: "memory");
        }
    }
    __syncthreads();
}


struct Args { const float* in[23]; float* out; unsigned char* ws; int ph_lo, ph_hi; };
enum { I_X = 0, I_N1, I_G1, I_U1, I_D1, I_MN, I_WIN, I_CW, I_CB, I_WA, I_BA, I_WX, I_BX, I_LAM, I_QN, I_KN, I_RON, I_AON, I_WOUT, I_N2, I_G2, I_U2, I_D2 };

__device__ __forceinline__ void transpose_item(const float* W, int K, int N, const float* gk, bf16_t* WT, int dst_row0, float* scr, int k0, int n0, int lane) {
    float wv[32];
#pragma unroll
    for (int i = 0; i < 32; ++i) wv[i] = __builtin_nontemporal_load(W + (size_t)(k0 + 2 * i + (lane >> 5)) * N + n0 + (lane & 31));
    if (gk) {
#pragma unroll
        for (int i = 0; i < 32; ++i) wv[i] *= gk[k0 + 2 * i + (lane >> 5)]; }
#pragma unroll
    for (int i = 0; i < 32; ++i) scr[(2 * i + (lane >> 5)) * 33 + (lane & 31)] = wv[i];
    asm volatile("s_waitcnt lgkmcnt(0)" ::: "memory");
    const int c = lane & 7;
#pragma unroll
    for (int j = 0; j < 4; ++j) { const int n = (lane >> 3) + 8 * j; const float* s = scr + (8 * c) * 33 + n;
        u32x4 o; o.x = pk_bf16(s[0 * 33], s[1 * 33]); o.y = pk_bf16(s[2 * 33], s[3 * 33]); o.z = pk_bf16(s[4 * 33], s[5 * 33]); o.w = pk_bf16(s[6 * 33], s[7 * 33]);
        *(u32x4*)(WT + (size_t)(dst_row0 + n) * K + k0 + 8 * c) = o; }
    asm volatile("s_waitcnt lgkmcnt(0)" ::: "memory");
}
constexpr int CV_F = (DM / 64) * (DFF / 32), CV_IN = (DM / 64) * (NIN / 32), CV_O = (DM / 64) * (DM / 32);
constexpr int CV_P0_END = 2 * CV_F, CV_A_END = 3 * CV_F, CV_B_END = CV_A_END + CV_IN + CV_O + CV_F, CV_END = CV_B_END + 2 * CV_F;
__device__ __forceinline__ void convert_item(const Args& a, float* scr, int id, int lane) {
    unsigned char* ws = a.ws; int r = id;
    if (r < 2 * CV_F || r >= CV_B_END) {
        const int ffn = r >= CV_B_END; if (ffn) r -= CV_B_END; const int up = r / CV_F; r -= up * CV_F;
        const float* W = a.in[ffn ? (up ? I_U2 : I_G2) : (up ? I_U1 : I_G1)]; const float* g = a.in[ffn ? I_N2 : I_N1];
        bf16_t* WT = (bf16_t*)(ws + (ffn ? WS_WGU2 : WS_WGU1));
        const int nblk = DFF / 32, kb = r / nblk, nb = r % nblk, n0 = 32 * nb;
        transpose_item(W, DM, DFF, g, WT, 256 * (n0 / 128) + 128 * up + (n0 % 128), scr, 64 * kb, n0, lane); return; }
    if (r < CV_A_END || r >= CV_A_END + CV_IN + CV_O) {
        const int ffn = r >= CV_A_END; r -= ffn ? (CV_A_END + CV_IN + CV_O) : 2 * CV_F;
        const int nblk = DM / 32, kb = r / nblk, nb = r % nblk, n0 = 32 * nb;
        transpose_item(a.in[ffn ? I_D2 : I_D1], DFF, DM, nullptr, (bf16_t*)(ws + (ffn ? WS_WD2 : WS_WD1)), n0, scr, 64 * kb, n0, lane); return; }
    r -= CV_A_END;
    if (r < CV_IN) {
        const int nblk = NIN / 32, kb = r / nblk, nb = r % nblk, n0 = 32 * nb, o = n0 % 256, wc = o / 64, bj = (o % 64) / 32;
        transpose_item(a.in[I_WIN], DM, NIN, a.in[I_MN], (bf16_t*)(ws + WS_WIN), (n0 - o) + 128 * bj + 32 * wc, scr, 64 * kb, n0, lane); return; }
    r -= CV_IN;
    { const int nblk = DM / 32, kb = r / nblk, nb = r % nblk, n0 = 32 * nb;
      transpose_item(a.in[I_WOUT], DM, DM, nullptr, (bf16_t*)(ws + WS_WOUT), n0, scr, 64 * kb, n0, lane); }
}
__device__ __forceinline__ void convert_range(const Args& a, unsigned char* lds, int first, int last, int w, int NW, int wave, int lane) {
    float* scr = (float*)(lds + wave * 16384);
    for (int id = first + w; id < last; id += NW) convert_item(a, scr, id, lane);
}
__device__ __forceinline__ void phase_prologue(const Args& a, unsigned char* lds, int gw, int NGW, int wave, int lane, bool split) {
    unsigned char* ws = a.ws;
    convert_range(a, lds, 0, split ? CV_P0_END : CV_END, gw, NGW, wave, lane);
    const float* x = a.in[I_X]; bf16_t* xb = (bf16_t*)(ws + WS_XB); float* ssq = (float*)(ws + WS_SSQ);
    const int rbase = split ? 2048 * ((gw >> 3) & 7) + 64 * (gw >> 6) + (gw & 7) : gw, rstep = split ? 8 : NGW, rend = split ? rbase + 64 : T;
    for (int m0 = rbase; m0 < rend; m0 += 8 * rstep) {
        f32x4 v[8][4]; float sq[8];
#pragma unroll
        for (int q = 0; q < 8; ++q) { const int m = (m0 + q * rstep < rend) ? m0 + q * rstep : m0; const f32x4* xr = (const f32x4*)(x + (size_t)m * DM) + lane;
#pragma unroll
            for (int j = 0; j < 4; ++j) v[q][j] = __builtin_nontemporal_load(xr + 64 * j); }
#pragma unroll
        for (int q = 0; q < 8; ++q) { float t = 0.f;
#pragma unroll
            for (int j = 0; j < 4; ++j) t += (v[q][j][0] * v[q][j][0] + v[q][j][1] * v[q][j][1]) + (v[q][j][2] * v[q][j][2] + v[q][j][3] * v[q][j][3]);
            sq[q] = wave_sum(t); }
#pragma unroll
        for (int q = 0; q < 8; ++q) { const int m = m0 + q * rstep; if (m < rend) { u32x2* o = (u32x2*)(xb + (size_t)m * DM) + lane;
#pragma unroll
            for (int j = 0; j < 4; ++j) { u32x2 w; w.x = pk_bf16(v[q][j][0], v[q][j][1]); w.y = pk_bf16(v[q][j][2], v[q][j][3]); o[64 * j] = w; }
            if (lane < 16) ssq[(size_t)m * 16 + lane] = (lane == 0) ? sq[q] : 0.f; } }
    }
    { unsigned long long* gr = (unsigned long long*)(ws + WS_GRAN); for (int i = gw * 64 + lane; i < 4 * NCHUNK * DRNN; i += NGW * 64) gr[i] = 0ull; }
    for (int idx = gw * 64 + lane; idx < 2 * 8 * 2 * 4 * 64; idx += NGW * 64) {
        const int l = idx & 63, ks = (idx >> 6) & 3, half = (idx >> 8) & 1, n = (idx >> 9) & 7, mat = idx >> 12;
        const float* w = a.in[mat ? I_WX : I_WA] + (size_t)(n * 64 + 16 * ks + 8 * (l >> 5)) * 64 + 32 * half + (l & 31);
        u32x4 pkd; pkd.x = pk_bf16(w[0], w[64]); pkd.y = pk_bf16(w[128], w[192]); pkd.z = pk_bf16(w[256], w[320]); pkd.w = pk_bf16(w[384], w[448]);
        ((u32x4*)(ws + WS_WPK))[idx] = pkd;
    }
}

typedef short bf16x8_t __attribute__((ext_vector_type(8)));
typedef float f32x16 __attribute__((ext_vector_type(16)));
__device__ __forceinline__ int crow(int r, int hi) { return (r & 3) + 8 * (r >> 2) + 4 * hi; }
__device__ __forceinline__ float sigmoid_fast(float x) { return __builtin_amdgcn_rcpf(1.0f + __builtin_amdgcn_exp2f(-1.4426950408889634f * x)); }
__device__ __forceinline__ void rnn_item(const Args& a, int item, unsigned char* wl, int lane) {
    constexpr int XP = 144;
    const int b = item >> 9, n = (item >> 6) & 7, c = item & 63, ql = lane & 31, hi = lane >> 5;
    unsigned char* ws = a.ws;
    const bf16_t* PROJ = (const bf16_t*)(ws + WS_PROJ); unsigned* HPg = (unsigned*)(ws + WS_H);
    const size_t row0 = (size_t)b * SEQ + (size_t)c * 64;
    u32x4 wfr[2][2][4];
#pragma unroll
    for (int mat = 0; mat < 2; ++mat)
#pragma unroll
        for (int hf = 0; hf < 2; ++hf)
#pragma unroll
            for (int ks = 0; ks < 4; ++ks) wfr[mat][hf][ks] = ((const u32x4*)(ws + WS_WPK))[(((mat * 8 + n) * 2 + hf) * 4 + ks) * 64 + lane];
    {
        const int ch = n * 64 + lane, tr = lane >> 3, ck = lane & 7;
        const float cw0 = a.in[I_CW][ch], cw1 = a.in[I_CW][512 + ch], cw2 = a.in[I_CW][1024 + ch], cw3 = a.in[I_CW][1536 + ch], cb = a.in[I_CB][ch];
        const bf16_t* xt = PROJ + row0 * NIN + n * 64 + 8 * ck;
        u32x4 xq[8], xh = {0u, 0u, 0u, 0u};
#pragma unroll
        for (int i = 0; i < 8; ++i) xq[i] = *(const u32x4*)(xt + (size_t)(tr + 8 * i) * NIN);
        if (c > 0 && lane < 24) xh = *(const u32x4*)(xt - (size_t)(3 - tr) * NIN);
#pragma unroll
        for (int i = 0; i < 8; ++i) *(u32x4*)(wl + (tr + 8 * i + 3) * XP + 16 * ck) = xq[i];
        if (lane < 24) *(u32x4*)(wl + tr * XP + 16 * ck) = xh;
        asm volatile("s_waitcnt lgkmcnt(0)" ::: "memory");
        float xm3 = bf_1(((const bf16_t*)(wl + 0 * XP))[lane]), xm2 = bf_1(((const bf16_t*)(wl + 1 * XP))[lane]), xm1 = bf_1(((const bf16_t*)(wl + 2 * XP))[lane]);
#pragma unroll
        for (int t = 0; t < 64; ++t) { const float x0 = bf_1(((const bf16_t*)(wl + (t + 3) * XP))[lane]); const float xc = cb + cw0 * xm3 + cw1 * xm2 + cw2 * xm1 + cw3 * x0;
            ((bf16_t*)(wl + t * XP))[lane] = (bf16_t)(pk_bf16(xc, xc) & 0xffffu); xm3 = xm2; xm2 = xm1; xm1 = x0; }
    }
    asm volatile("s_waitcnt lgkmcnt(0)" ::: "memory");
#pragma unroll
    for (int dblk = 0; dblk < 2; ++dblk) {
        const int d = 32 * dblk + ql, ch = n * 64 + d;
        bf16x8_t bfa[4], bfx[4];
#pragma unroll
        for (int ks = 0; ks < 4; ++ks) { bfa[ks] = __builtin_bit_cast(bf16x8_t, wfr[0][dblk][ks]); bfx[ks] = __builtin_bit_cast(bf16x8_t, wfr[1][dblk][ks]); }
        const float ba = a.in[I_BA][ch], bx = a.in[I_BX][ch], lam = a.in[I_LAM][ch];
        const float lsl8 = -8.0f * (fmaxf(-lam, 0.f) + log1pf(expf(-fabsf(lam))));
        float cH = 0.f, cP = 1.f;
#pragma unroll
        for (int tb = 0; tb < 2; ++tb) {
            f32x16 R, I;
#pragma unroll
            for (int r = 0; r < 16; ++r) { R[r] = 0.f; I[r] = 0.f; }
#pragma unroll
            for (int ks = 0; ks < 4; ++ks) { const bf16x8_t af = *(const bf16x8_t*)(wl + (32 * tb + ql) * XP + (16 * ks + 8 * hi) * 2);
                R = __builtin_amdgcn_mfma_f32_32x32x16_bf16(af, bfa[ks], R, 0, 0, 0); I = __builtin_amdgcn_mfma_f32_32x32x16_bf16(af, bfx[ks], I, 0, 0, 0); }
            float Hl[16], Pl[16], Ar[4], Br[4];
#pragma unroll
            for (int g = 0; g < 4; ++g) {
                float H = 0.f, P = 1.f;
#pragma unroll
                for (int e = 0; e < 4; ++e) {
                    const int r = 4 * g + e, t = 32 * tb + crow(r, hi);
                    const float rg = sigmoid_fast(R[r] + ba), ig = sigmoid_fast(I[r] + bx);
                    const float la = rg * lsl8, av = __builtin_amdgcn_exp2f(1.4426950408889634f * la), y = 2.0f * la;
                    const float ser = -y * (1.0f + y * 0.5f * (1.0f + y * (1.0f / 3.0f) * (1.0f + y * 0.25f)));
                    const float m2 = (y > -0.0137f) ? ser : (1.0f - av * av);
                    const float xcv = bf_1(((const bf16_t*)(wl + t * XP))[d]);
                    const float bv = __builtin_sqrtf(m2) * (ig * xcv);
                    H = av * H + bv; P *= av; Hl[r] = H; Pl[r] = P;
                }
                Ar[g] = P; Br[g] = H;
            }
            float myH[4], myP[4];
#pragma unroll
            for (int g = 0; g < 4; ++g) {
                const float pA = __shfl_xor(Ar[g], 32), pB = __shfl_xor(Br[g], 32);
                const float A0 = hi ? pA : Ar[g], B0 = hi ? pB : Br[g], A1 = hi ? Ar[g] : pA, B1 = hi ? Br[g] : pB;
                const float eH = cH, eP = cP;
                cH = A0 * cH + B0; cP = A0 * cP;
                myH[g] = hi ? cH : eH; myP[g] = hi ? cP : eP;
                cH = A1 * cH + B1; cP = A1 * cP;
            }
#pragma unroll
            for (int r = 0; r < 16; ++r) {
                const size_t o = (row0 + 32 * tb + crow(r, hi)) * DRNN + ch;
                HPg[o] = pk_bf16(Hl[r] + Pl[r] * myH[r >> 2], Pl[r] * myP[r >> 2]);
            }
        }
        if (hi == 0) {
            __hip_atomic_store((gu64*)(ws + WS_GRAN) + (size_t)(b * NCHUNK + c) * DRNN + ch, ((unsigned long long)__float_as_uint(cH) << 32) | (unsigned long long)(__float_as_uint(cP) | 1u), RLX_AGENT); }
    }
    asm volatile("s_waitcnt lgkmcnt(0)" ::: "memory");
}

typedef short s16x4_t __attribute__((ext_vector_type(4)));
typedef __attribute__((address_space(3))) s16x4_t* lds_s16x4_ptr;
constexpr int VPITCH = 192;
#define ATT_LOADK(KQ, tile) do { const int t_ = (tile) > 0 ? (tile) : 0; \
        _Pragma("unroll") for (int i = 0; i < 4; ++i) KQ[i] = *(const u32x4*)(kbase + (size_t)(t_ * 32 + (lane >> 3) + 8 * i) * NIN); } while (0)
#define ATT_LOADV(VV, tile) do { const int t_ = (tile) > 0 ? (tile) : 0; \
        _Pragma("unroll") for (int i = 0; i < 4; ++i) VV[i] = *(const u32x4*)(vbase + (size_t)(t_ * 32 + (lane >> 3) + 8 * i) * NIN); } while (0)
constexpr int KPITCH = 144, KLDS_OFF = 32 * VPITCH;
struct AttnPre { bf16x8_t qf[4]; u32x4 kq[4], kq1[4], vv[4], vn[4]; };
__device__ __forceinline__ void attn_fetch(const bf16_t* PROJ, int item, int lane, AttnPre& P) {
    const int b = item >> 10, h = (item >> 7) & 7, qt = item & 127, ql = lane & 31, hi = lane >> 5;
    const size_t rowb = (size_t)b * SEQ;
    const bf16_t* qrow = PROJ + (rowb + qt * 32 + ql) * NIN + 1024 + h * 64;
    const bf16_t* kbase = PROJ + rowb * NIN + 1536 + h * 64 + 8 * (lane & 7);
    const bf16_t* vbase = PROJ + rowb * NIN + 2048 + h * 64 + 8 * (lane & 7);
#pragma unroll
    for (int d0 = 0; d0 < 4; ++d0) P.qf[d0] = *(const bf16x8_t*)(qrow + 16 * d0 + 8 * hi);
    ATT_LOADK(P.kq, qt); ATT_LOADV(P.vv, qt); ATT_LOADK(P.kq1, qt - 1); ATT_LOADV(P.vn, qt - 1);
}
__device__ __forceinline__ void attn_wave(const Args& a, int first, int stride, int end, unsigned char* vlds, int lane) {
  if (first >= end) return;
  bf16_t* PROJ = (bf16_t*)(a.ws + WS_PROJ);
  AttnPre P; attn_fetch(PROJ, first, lane, P);
  for (int item = first;;) {
    const int b = item >> 10, h = (item >> 7) & 7, qt = item & 127;
    const size_t rowb = (size_t)b * SEQ; const int ql = lane & 31, hi = lane >> 5;
    bf16x8_t qf[4], kf[4]; u32x4 kq[4], vv[4], vn[4];
    unsigned char* kst = vlds + KLDS_OFF + (lane >> 3) * KPITCH + 16 * (lane & 7);
    const unsigned char* kfr = vlds + KLDS_OFF + ql * KPITCH + 16 * hi;
#pragma unroll
    for (int i = 0; i < 4; ++i) { qf[i] = P.qf[i]; vv[i] = P.vv[i]; vn[i] = P.vn[i]; *(u32x4*)(kst + 8 * i * KPITCH) = P.kq[i]; kq[i] = P.kq1[i]; }
#pragma unroll
    for (int d0 = 0; d0 < 4; ++d0) kf[d0] = *(const bf16x8_t*)(kfr + 32 * d0);
    f32x16 o0, o1;
#pragma unroll
    for (int r = 0; r < 16; ++r) { o0[r] = 0.f; o1[r] = 0.f; }
    float C = 0.f;
    const bf16_t* kbase = PROJ + rowb * NIN + 1536 + h * 64 + 8 * (lane & 7);
    const bf16_t* vbase = PROJ + rowb * NIN + 2048 + h * 64 + 8 * (lane & 7);
    unsigned char* vst = vlds + (lane >> 3) * VPITCH + 16 * (lane & 7);
    const lds_s16x4_ptr vtr0 = (lds_s16x4_ptr)(__attribute__((address_space(3))) unsigned char*)(vlds + (4 * hi + ((lane & 15) >> 2)) * VPITCH + (16 * ((lane >> 4) & 1) + 4 * (lane & 3)) * 2);
    for (int kt = qt; kt >= 0; --kt) {
        f32x16 p;
#pragma unroll
        for (int r = 0; r < 16; ++r) p[r] = 0.f;
#pragma unroll
        for (int d0 = 0; d0 < 4; ++d0) p = __builtin_amdgcn_mfma_f32_32x32x16_bf16(kf[d0], qf[d0], p, 0, 0, 0);
#pragma unroll
        for (int i = 0; i < 4; ++i) { *(u32x4*)(vst + 8 * i * VPITCH) = vv[i]; *(u32x4*)(kst + 8 * i * KPITCH) = kq[i]; vv[i] = vn[i]; }
        ATT_LOADK(kq, kt - 2); ATT_LOADV(vn, kt - 2);
        const bool diag = (kt == qt);
        float be[16], om[16];
#pragma unroll
        for (int r = 0; r < 16; ++r) {
            const float z = p[r];
            const float e = __builtin_amdgcn_exp2f(-1.4426950408889634f * __builtin_fabsf(z)), rc = __builtin_amdgcn_rcpf(1.0f + e), er = e * rc;
            const bool pos = z >= 0.f;
            be[r] = pos ? rc : er; om[r] = pos ? er : rc;
        }
        if (diag) {
#pragma unroll
            for (int r = 0; r < 16; ++r) { const bool act = crow(r, hi) < ql; be[r] = act ? be[r] : 0.f; om[r] = act ? om[r] : 1.0f; }
        }
        float s2[4], s1[4], s0[4], t[4], u[4];
#pragma unroll
        for (int g = 0; g < 4; ++g) { s2[g] = om[4 * g + 3]; s1[g] = s2[g] * om[4 * g + 2]; s0[g] = s1[g] * om[4 * g + 1]; const float G = s0[g] * om[4 * g]; t[g] = __shfl_xor(G, 32); u[g] = G * t[g]; }
        float U[4]; U[3] = 1.0f; U[2] = u[3]; U[1] = u[3] * u[2]; U[0] = U[1] * u[1];
        const float total = U[0] * u[0];
        const float eC = __builtin_amdgcn_exp2f(1.4426950408889634f * C);
        float w[16];
#pragma unroll
        for (int g = 0; g < 4; ++g) {
            const float base = eC * U[g] * (hi == 0 ? t[g] : 1.0f);
            w[4 * g + 3] = be[4 * g + 3] * base; w[4 * g + 2] = be[4 * g + 2] * (s2[g] * base); w[4 * g + 1] = be[4 * g + 1] * (s1[g] * base); w[4 * g] = be[4 * g] * (s0[g] * base);
        }
        C += 0.6931471805599453f * __builtin_amdgcn_logf(total);
        u32x4 wp0, wp1;
        wp0.x = pk_bf16(w[0], w[1]); wp0.y = pk_bf16(w[2], w[3]); wp0.z = pk_bf16(w[4], w[5]); wp0.w = pk_bf16(w[6], w[7]);
        wp1.x = pk_bf16(w[8], w[9]); wp1.y = pk_bf16(w[10], w[11]); wp1.z = pk_bf16(w[12], w[13]); wp1.w = pk_bf16(w[14], w[15]);
        const bf16x8_t wf0 = __builtin_bit_cast(bf16x8_t, wp0), wf1 = __builtin_bit_cast(bf16x8_t, wp1);
        asm volatile("s_waitcnt lgkmcnt(0)" ::: "memory");
#pragma unroll
        for (int dblk = 0; dblk < 2; ++dblk)
#pragma unroll
            for (int ks = 0; ks < 2; ++ks) {
                const s16x4_t lo = __builtin_bit_cast(s16x4_t, __builtin_amdgcn_ds_read_tr16_b64_v4i16((lds_s16x4_ptr)((__attribute__((address_space(3))) unsigned char*)vtr0 + (16 * ks) * VPITCH + 64 * dblk)));
                const s16x4_t hh = __builtin_bit_cast(s16x4_t, __builtin_amdgcn_ds_read_tr16_b64_v4i16((lds_s16x4_ptr)((__attribute__((address_space(3))) unsigned char*)vtr0 + (16 * ks + 8) * VPITCH + 64 * dblk)));
                const bf16x8_t vf = (bf16x8_t){lo[0], lo[1], lo[2], lo[3], hh[0], hh[1], hh[2], hh[3]};
                if (dblk == 0) o0 = __builtin_amdgcn_mfma_f32_32x32x16_bf16(vf, ks ? wf1 : wf0, o0, 0, 0, 0);
                else           o1 = __builtin_amdgcn_mfma_f32_32x32x16_bf16(vf, ks ? wf1 : wf0, o1, 0, 0, 0);
            }
        asm volatile("s_waitcnt lgkmcnt(0)" ::: "memory");
#pragma unroll
        for (int d0 = 0; d0 < 4; ++d0) kf[d0] = *(const bf16x8_t*)(kfr + 32 * d0);
        if (__all(C < -104.0f)) break;
    }
    const int nxt = item + stride; const bool more = nxt < end;
    if (more) attn_fetch(PROJ, nxt, lane, P);
    bf16_t* yrow = (bf16_t*)(a.ws + WS_Y) + (rowb + qt * 32 + ql) * DM + 512 + h * 64;
#pragma unroll
    for (int g = 0; g < 4; ++g) {
        u32x2 w0, w1; w0.x = pk_bf16(o0[4 * g], o0[4 * g + 1]); w0.y = pk_bf16(o0[4 * g + 2], o0[4 * g + 3]); w1.x = pk_bf16(o1[4 * g], o1[4 * g + 1]); w1.y = pk_bf16(o1[4 * g + 2], o1[4 * g + 3]);
        *(u32x2*)(yrow + 8 * g + 4 * hi) = w0; *(u32x2*)(yrow + 32 + 8 * g + 4 * hi) = w1;
    }
    if (!more) break;
    item = nxt;
  }
}

#undef ATT_LOADK
#undef ATT_LOADV
__device__ __forceinline__ void finalize_unit(const Args& a, int unit, float* carry, int tid, int wave, int lane) {
    const int b = unit >> 6, c = unit & 63;
    unsigned char* ws = a.ws;
    const bf16_t* PROJ = (const bf16_t*)(ws + WS_PROJ); const unsigned* HP = (const unsigned*)(ws + WS_H);
    bf16_t* Y = (bf16_t*)(ws + WS_Y);
    { float cr = 0.f;
      gu64* gp = (gu64*)(ws + WS_GRAN) + (size_t)(b * NCHUNK) * DRNN + tid;
      for (int c0 = 0; c0 < c; c0 += 32) {
          unsigned long long x[32];
          for (unsigned spins = 0;; ++spins) {
              bool ok = true;
#pragma unroll
              for (int k = 0; k < 32; ++k) { x[k] = ((c0 + k) < c) ? __hip_atomic_load(gp + (size_t)(c0 + k) * DRNN, RLX_AGENT) : 1ull; ok = ok && ((x[k] & 1ull) != 0ull); }
              if (ok || spins > (1u << 16)) break;
              __builtin_amdgcn_s_sleep(4);
          }
#pragma unroll
          for (int k = 0; k < 32; ++k) if ((c0 + k) < c) cr = __uint_as_float((unsigned)x[k]) * cr + __uint_as_float((unsigned)(x[k] >> 32));
      }
      carry[tid] = cr; }
    __syncthreads();
    const f32x4 c0 = *(const f32x4*)(carry + 8 * lane), c1 = *(const f32x4*)(carry + 8 * lane + 4);
    const f32x4 gr0 = *(const f32x4*)(a.in[I_RON] + 8 * lane), gr1 = *(const f32x4*)(a.in[I_RON] + 8 * lane + 4);
    const f32x4 ga0 = *(const f32x4*)(a.in[I_AON] + 8 * lane), ga1 = *(const f32x4*)(a.in[I_AON] + 8 * lane + 4);
#pragma unroll
    for (int i = 0; i < 8; ++i) {
        const size_t row = (size_t)b * SEQ + (size_t)c * 64 + wave * 8 + i;
        const u32x4 hp0 = __builtin_nontemporal_load((const u32x4*)(HP + row * DRNN + 8 * lane)), hp1 = __builtin_nontemporal_load((const u32x4*)(HP + row * DRNN + 8 * lane + 4));
        const u32x4 gt = __builtin_nontemporal_load((const u32x4*)(PROJ + row * NIN + 512 + 8 * lane));
        const u32x4 ya = __builtin_nontemporal_load((const u32x4*)(Y + row * DM + 512 + 8 * lane));
        float y[8], z[8];
        y[0] = (bf_lo(hp0.x) + bf_hi(hp0.x) * c0[0]) * gelu_tanh(bf_lo(gt.x)); y[1] = (bf_lo(hp0.y) + bf_hi(hp0.y) * c0[1]) * gelu_tanh(bf_hi(gt.x));
        y[2] = (bf_lo(hp0.z) + bf_hi(hp0.z) * c0[2]) * gelu_tanh(bf_lo(gt.y)); y[3] = (bf_lo(hp0.w) + bf_hi(hp0.w) * c0[3]) * gelu_tanh(bf_hi(gt.y));
        y[4] = (bf_lo(hp1.x) + bf_hi(hp1.x) * c1[0]) * gelu_tanh(bf_lo(gt.z)); y[5] = (bf_lo(hp1.y) + bf_hi(hp1.y) * c1[1]) * gelu_tanh(bf_hi(gt.z));
        y[6] = (bf_lo(hp1.z) + bf_hi(hp1.z) * c1[2]) * gelu_tanh(bf_lo(gt.w)); y[7] = (bf_lo(hp1.w) + bf_hi(hp1.w) * c1[3]) * gelu_tanh(bf_hi(gt.w));
        z[0] = bf_lo(ya.x); z[1] = bf_hi(ya.x); z[2] = bf_lo(ya.y); z[3] = bf_hi(ya.y); z[4] = bf_lo(ya.z); z[5] = bf_hi(ya.z); z[6] = bf_lo(ya.w); z[7] = bf_hi(ya.w);
        float sy = 0.f, sz = 0.f;
#pragma unroll
        for (int e = 0; e < 8; ++e) { sy += y[e] * y[e]; sz += z[e] * z[e]; }
        sy = wave_sum(sy); sz = wave_sum(sz);
        const float ry = __builtin_amdgcn_rsqf(sy * (1.0f / 512.0f) + EPS), rz = __builtin_amdgcn_rsqf(sz * (1.0f / 512.0f) + EPS);
        u32x4 wy, wz;
        wy.x = pk_bf16(y[0] * ry * gr0[0], y[1] * ry * gr0[1]); wy.y = pk_bf16(y[2] * ry * gr0[2], y[3] * ry * gr0[3]); wy.z = pk_bf16(y[4] * ry * gr1[0], y[5] * ry * gr1[1]); wy.w = pk_bf16(y[6] * ry * gr1[2], y[7] * ry * gr1[3]);
        wz.x = pk_bf16(z[0] * rz * ga0[0], z[1] * rz * ga0[1]); wz.y = pk_bf16(z[2] * rz * ga0[2], z[3] * rz * ga0[3]); wz.z = pk_bf16(z[4] * rz * ga1[0], z[5] * rz * ga1[1]); wz.w = pk_bf16(z[6] * rz * ga1[2], z[7] * rz * ga1[3]);
        *(u32x4*)(Y + row * DM + 8 * lane) = wy; *(u32x4*)(Y + row * DM + 512 + 8 * lane) = wz;
    }
    __syncthreads();
}

__device__ __forceinline__ int panel_scales(const pg8::StaticOrder& S, const float* ssq, float* rsl, int tid) {
    pg8::Unit u0; int pm = -1;
    if (S.next(0, u0)) { pm = u0.pm;
        if (tid < 256) { const f32x4* p = (const f32x4*)(ssq + ((size_t)pm * 256 + tid) * 16); const f32x4 a = p[0], b = p[1], c = p[2], d = p[3];
            const float s = ((a[0] + a[1]) + (a[2] + a[3])) + ((b[0] + b[1]) + (b[2] + b[3])) + ((c[0] + c[1]) + (c[2] + c[3])) + ((d[0] + d[1]) + (d[2] + d[3]));
            rsl[tid] = __builtin_amdgcn_rsqf(s * (1.0f / 1024.0f) + 1e-6f); } }
    __syncthreads();
    return pm;
}

__global__ void __launch_bounds__(NTHR, 2) fwd_megakernel(Args a) {
    extern __shared__ __attribute__((aligned(16))) unsigned char lds[];
    cg::grid_group grid = cg::this_grid();
    const int tid = threadIdx.x, lane = tid & 63, wave = __builtin_amdgcn_readfirstlane(tid >> 6);
    const int G = gridDim.x, bx = blockIdx.x;
    const int gw = bx * NWAVES + wave, NGW = G * NWAVES;
    unsigned char* ws = a.ws;
    PG8_LAS unsigned char* glds = (PG8_LAS unsigned char*)lds;
    const int lo = a.ph_lo, hi = a.ph_hi;
    if (tid < 64) ((LAS unsigned*)(glds + LDS_CTL_OFF))[tid] = 0u;
    __syncthreads();
    XcdBarrier bar; bar.bar = (unsigned*)(ws + WS_BAR); bar.x = 0; bar.st = nullptr;
    if (hi - lo > 1) bar = xcd_barrier_post((unsigned*)(ws + WS_BAR), (volatile LAS unsigned*)(glds + LDS_CTL_OFF));
#define IN(k) (lo <= (k) && (k) < hi)
    if (a.ph_hi > N_PHASES) grid.sync();
#define SEAM(k) do { if (IN(k) && IN((k) + 1)) xcd_barrier(bar); } while (0)
    bf16_t* XB = (bf16_t*)(ws + WS_XB); float* SSQ0 = (float*)(ws + WS_SSQ); float* SSQ1 = SSQ0 + (size_t)T * 16; float* SSQ2 = SSQ1 + (size_t)T * 16;
    bf16_t* ACT = (bf16_t*)(ws + WS_ACT);

    const bool split = (G == 256);
    if (IN(0)) { REP(0) phase_prologue(a, lds, gw, NGW, wave, lane, split); SEAM(0); }
    if (IN(1)) {
        pg8::Gemm g{XB, (const bf16_t*)(ws + WS_WGU1), T, 2 * DFF, DM}; pg8::StaticOrder S; S.init(T, 2 * DFF, G, bx);
        float* rsl = (float*)(lds + LDS_RS_OFF); const int pmc = panel_scales(S, SSQ0, rsl, tid);
        pg8::EpiSwiGLU E{ACT, DFF, SSQ0, rsl, pmc};
        REP(1) pg8::gemm_phase<pg8::EpiSwiGLU, pg8::StaticOrder, true, true>(glds, g, S, E);
        if (split && bx >= 128) convert_range(a, lds, CV_P0_END, CV_B_END - CV_F, (bx - 128) * NWAVES + wave, 128 * NWAVES, wave, lane);
        SEAM(1); }
    if (IN(2)) {
        pg8::Gemm g{ACT, (const bf16_t*)(ws + WS_WD1), T, DM, DFF}; pg8::StaticOrder S; S.init(T, DM, G, bx);
        pg8::EpiResid E{XB, nullptr, XB, SSQ1, 0.5f};
        REP(2) pg8::gemm_phase<pg8::EpiResid, pg8::StaticOrder, true, true>(glds, g, S, E); SEAM(2); }
    if (IN(3)) {
        pg8::Gemm g{XB, (const bf16_t*)(ws + WS_WIN), T, NIN, DM}; pg8::StaticOrder S; S.init(T, NIN, G, bx);
        float* rsl = (float*)(lds + LDS_RS_OFF); const int pmc = panel_scales(S, SSQ1, rsl, tid);
        pg8::EpiInProj E{(bf16_t*)(ws + WS_PROJ), SSQ1, a.in[I_QN], a.in[I_KN], rsl, pmc};
        REP(3) pg8::gemm_phase<pg8::EpiInProj, pg8::StaticOrder, true, true>(glds, g, S, E);
        if (split && bx >= 128) convert_range(a, lds, CV_B_END - CV_F, CV_END, (bx - 128) * NWAVES + wave, 128 * NWAVES, wave, lane);
        SEAM(3); }
    if (IN(4)) {
        { const int gc = 32 * (bx & 7) + (bx >> 3), b = gc >> 6, c = gc & 63, hw = bx * 4 + (wave & 3), NHW = G * 4, w2 = wave - 4;
          if (wave < 4) { const int id0 = split ? ((b << 9) | (wave << 6) | c) : hw, idstep = split ? 256 : NHW, idend = split ? id0 + 512 : 2048;
              __builtin_amdgcn_s_setprio(2); REP(4) for (int it = id0; it < idend; it += idstep) rnn_item(a, it, lds + wave * 16384, lane); __builtin_amdgcn_s_setprio(0); }
          else { const int first = split ? ((b << 10) | ((4 * (w2 & 1)) << 7) | (2 * c + (w2 >> 1))) : hw;
              REP(41) attn_wave(a, first, split ? 128 : NHW, split ? first + 512 : 4096, lds + wave * 16384, lane); } }
        if (!split) SEAM(4); }
    if (IN(5)) { if (split && IN(4)) { asm volatile("s_waitcnt vmcnt(0)" ::: "memory"); __syncthreads(); }
                 REP(5) for (int u = split ? 32 * (bx & 7) + (bx >> 3) : bx; u < 4 * NCHUNK; u += split ? 4 * NCHUNK : G) finalize_unit(a, u, (float*)lds, tid, wave, lane); SEAM(5); }
    if (IN(6)) {
        pg8::Gemm g{(const bf16_t*)(ws + WS_Y), (const bf16_t*)(ws + WS_WOUT), T, DM, DM}; pg8::StaticOrder S; S.init(T, DM, G, bx);
        pg8::EpiResid E{XB, nullptr, XB, SSQ2, 1.0f};
        pg8::gemm_phase<pg8::EpiResid, pg8::StaticOrder, true, true>(glds, g, S, E); SEAM(6); }
    if (IN(7)) {
        pg8::Gemm g{XB, (const bf16_t*)(ws + WS_WGU2), T, 2 * DFF, DM}; pg8::StaticOrder S; S.init(T, 2 * DFF, G, bx);
        float* rsl = (float*)(lds + LDS_RS_OFF); const int pmc = panel_scales(S, SSQ2, rsl, tid);
        pg8::EpiSwiGLU E{ACT, DFF, SSQ2, rsl, pmc};
        pg8::gemm_phase<pg8::EpiSwiGLU, pg8::StaticOrder, true, true>(glds, g, S, E); SEAM(7); }
    if (IN(8)) {
        pg8::Gemm g{ACT, (const bf16_t*)(ws + WS_WD2), T, DM, DFF}; pg8::StaticOrder S; S.init(T, DM, G, bx);
        pg8::EpiResid E{XB, a.out, nullptr, nullptr, 0.5f};
        pg8::gemm_phase<pg8::EpiResid, pg8::StaticOrder, true, true>(glds, g, S, E); }
#undef IN
#undef SEAM
}

extern "C" void kernel_launch(void* const* d_in, const int* in_sizes, int n_in, void* d_out, int out_size, void* d_ws, size_t ws_size, hipStream_t stream) {
    static int grid = 0;
    if (grid == 0) {
        if (n_in != 23 || in_sizes[0] != T * DM || out_size != T * DM || ws_size < WS_END2) { fprintf(stderr, "kernel_launch: unexpected shapes (n_in %d, in0 %d, out %d, ws %zu)\n", n_in, n_in > 0 ? in_sizes[0] : -1, out_size, ws_size); grid = -1; return; }
        int dev = 0, cus = 0, per_cu = 0;
        hipGetDevice(&dev); hipDeviceGetAttribute(&cus, hipDeviceAttributeMultiprocessorCount, dev);
        if (hipFuncSetAttribute((const void*)fwd_megakernel, hipFuncAttributeMaxDynamicSharedMemorySize, LDS_BYTES) != hipSuccess) { fprintf(stderr, "kernel_launch: hipFuncSetAttribute failed\n"); grid = -1; return; }
        if (hipOccupancyMaxActiveBlocksPerMultiprocessor(&per_cu, (const void*)fwd_megakernel, NTHR, LDS_BYTES) != hipSuccess || per_cu < 1) { fprintf(stderr, "kernel_launch: occupancy query says %d\n", per_cu); per_cu = 1; }
        (void)hipGetLastError();
        grid = cus * 1;
        if (grid <= 0) grid = 256;
    }
    if (grid < 0) return;
    Args a{};
    for (int i = 0; i < 23; ++i) a.in[i] = (const float*)d_in[i];
    a.out = (float*)d_out; a.ws = (unsigned char*)d_ws;
#if MK_LAUNCHES == 1
    if (hipMemsetAsync((char*)d_ws + WS_BAR, 0, BAR_ZERO_BYTES, stream) != hipSuccess) { fprintf(stderr, "kernel_launch: memset failed\n"); return; }
    a.ph_lo = 0; a.ph_hi = N_PHASES;
    void* args[] = {&a};
    hipError_t e = hipLaunchCooperativeKernel((const void*)fwd_megakernel, dim3(grid), dim3(NTHR), args, LDS_BYTES, stream);
    if (e != hipSuccess) fprintf(stderr, "kernel_launch: cooperative launch failed: %s (grid %d)\n", hipGetErrorString(e), grid);
#else
    for (int p = 0; p < N_PHASES; ++p) { a.ph_lo = p; a.ph_hi = p + 1; hipLaunchKernelGGL(fwd_megakernel, dim3(grid), dim3(NTHR), LDS_BYTES, stream, a); }
#endif
}
```

```cpp
#include <hip/hip_runtime.h>
#include <cstdio>
#include <cstdint>
namespace pg8 {
#define PG8_LAS __attribute__((address_space(3)))
typedef unsigned short bf16_t;
typedef short bf16x8 __attribute__((ext_vector_type(8)));
typedef float f32x4 __attribute__((ext_vector_type(4)));
typedef unsigned u32x4 __attribute__((ext_vector_type(4)));
constexpr int BM = 256, BK = 64, HALF = 128, HTB = HALF * BK * 2  , STAGE_BYTES = 8 * HTB, NXCD = 8, WGM = 8;

__host__ __device__ __forceinline__ int lds_byte(int r, int c) { const int st = (r >> 4) * 2 + (c >> 5), rr = r & 15, cc = c & 31, ob = rr * 64 + cc * 2; return st * 1024 + (ob ^ (((ob >> 9) & 1) << 5)); }
__host__ __device__ __forceinline__ void stage_rc(int b, int& R, int& C) { const int st = b / 1024, sb = b % 1024, swz = sb ^ (((sb >> 9) & 1) << 5); R = (st >> 1) * 16 + swz / 64; C = (st & 1) * 32 + (swz % 64) / 2; }
__host__ __device__ __forceinline__ int perm32(int rho) { const int n = rho >> 4, i = rho & 15; return 8 * (i >> 2) + 4 * n + (i & 3); }

struct Unit { int pm, pn; };
struct Gemm { const bf16_t* A; const bf16_t* Bt; int M, N, K; };

struct StaticOrder {
    int nM, nN, nwg, G, c;
    __host__ __device__ void init(int M, int N, int G_, int c_) { nM = M / BM; nN = N / BM; nwg = nM * nN; G = G_; c = c_; }
    __host__ __device__ bool next(int i, Unit& u) const {
        const long L = (long)i * G + c; if (L >= nwg) return false;
        int wgid = (int)L; { const int q = nwg / NXCD, r = nwg % NXCD, xcd = wgid % NXCD, off = wgid / NXCD; wgid = (xcd < r ? xcd * (q + 1) : r * (q + 1) + (xcd - r) * q) + off; }
        const int nig = WGM * nN, gid = wgid / nig, fm = gid * WGM, gsz = (nM - fm) < WGM ? (nM - fm) : WGM;
        u.pm = fm + ((wgid % nig) % gsz); u.pn = (wgid % nig) / gsz; return true;
    }
    __device__ __forceinline__ void a_ready(const Unit&) const {}
    __device__ __forceinline__ void done(const Unit&) const {}
};

__device__ __forceinline__ unsigned cvt_pk_bf16(float lo, float hi) { unsigned r; asm volatile("v_cvt_pk_bf16_f32 %0, %1, %2" : "=v"(r) : "v"(lo), "v"(hi)); return r; }
typedef float f32x2 __attribute__((ext_vector_type(2)));

__device__ __forceinline__ float row_rs(const float* ssq, int row, int fq, float inv_n, float eps) {
    const f32x4 a = *(const f32x4*)(ssq + (size_t)row * 16 + 4 * fq);
    float s = (a[0] + a[1]) + (a[2] + a[3]);
    s += __shfl_xor(s, 16); s += __shfl_xor(s, 32);
    return __builtin_amdgcn_rsqf(s * inv_n + eps);
}
__device__ __forceinline__ float silu_mul(float g, float up) { return g * __builtin_amdgcn_rcpf(1.0f + __builtin_amdgcn_exp2f(-1.4426950408889634f * g)) * up; }

struct EpiSwiGLU {
    static constexpr bool PERM = true, AFTER_DRAIN = false;
    bf16_t* O; int ldc; const float* ssq; const float* rsl; int pm_c;
    __device__ __forceinline__ void operator()(const f32x4 (&acc)[2][2][4][2], const Unit& u, int wr, int wc, int fr, int fq) const {
        const int row0 = u.pm * BM + wr * 64 + fr, col0 = u.pn * HALF + wc * 32 + 8 * fq;
        float rsv[2][4];
        if (u.pm == pm_c) {
#pragma unroll
            for (int ai = 0; ai < 2; ++ai)
#pragma unroll
                for (int m = 0; m < 4; ++m) rsv[ai][m] = rsl[ai * HALF + wr * 64 + m * 16 + fr];
        } else {
            asm volatile("" ::: "memory");
#pragma unroll
            for (int ai = 0; ai < 2; ++ai)
#pragma unroll
                for (int m = 0; m < 4; ++m) rsv[ai][m] = row_rs(ssq, row0 + ai * HALF + m * 16, fq, 1.0f / 1024.0f, 1e-6f);
        }
#pragma unroll
        for (int ai = 0; ai < 2; ++ai)
#pragma unroll
            for (int m = 0; m < 4; ++m) {
                const int row = row0 + ai * HALF + m * 16;
                const float rs = rsv[ai][m];
                float o[8];
#pragma unroll
                for (int n = 0; n < 2; ++n)
#pragma unroll
                    for (int e = 0; e < 4; ++e) o[n * 4 + e] = silu_mul(acc[ai][0][m][n][e] * rs, acc[ai][1][m][n][e] * rs);
                u32x4 w; w.x = cvt_pk_bf16(o[0], o[1]); w.y = cvt_pk_bf16(o[2], o[3]); w.z = cvt_pk_bf16(o[4], o[5]); w.w = cvt_pk_bf16(o[6], o[7]);
                *(u32x4*)(O + (size_t)row * ldc + col0) = w;
            }
    }
};

struct EpiResid {
    static constexpr bool PERM = true, AFTER_DRAIN = false;
    const bf16_t* rb; float* outf; bf16_t* xb; float* ssq_out; float alpha;
    __device__ __forceinline__ void operator()(const f32x4 (&acc)[2][2][4][2], const Unit& u, int wr, int wc, int fr, int fq) const {
        const int row0 = u.pm * BM + wr * 64 + fr, col0 = u.pn * BM + wc * 32 + 8 * fq;
        u32x4 rv[2][4][2];
#pragma unroll
        for (int ai = 0; ai < 2; ++ai)
#pragma unroll
            for (int m = 0; m < 4; ++m)
#pragma unroll
                for (int bj = 0; bj < 2; ++bj) rv[ai][m][bj] = *(const u32x4*)(rb + (size_t)(row0 + ai * HALF + m * 16) * 1024 + col0 + bj * HALF);
#pragma unroll
        for (int ai = 0; ai < 2; ++ai)
#pragma unroll
            for (int m = 0; m < 4; ++m) {
                const int row = row0 + ai * HALF + m * 16; float s = 0.f;
#pragma unroll
                for (int bj = 0; bj < 2; ++bj) {
                    const size_t off = (size_t)row * 1024 + col0 + bj * HALF; const u32x4 r = rv[ai][m][bj];
                    const f32x4 r0 = {__uint_as_float(r.x << 16), __uint_as_float(r.x & 0xffff0000u), __uint_as_float(r.y << 16), __uint_as_float(r.y & 0xffff0000u)};
                    const f32x4 r1 = {__uint_as_float(r.z << 16), __uint_as_float(r.z & 0xffff0000u), __uint_as_float(r.w << 16), __uint_as_float(r.w & 0xffff0000u)};
                    const f32x4 v0 = r0 + acc[ai][bj][m][0] * alpha, v1 = r1 + acc[ai][bj][m][1] * alpha;
                    if (outf) { __builtin_nontemporal_store(v0, (f32x4*)(outf + off)); __builtin_nontemporal_store(v1, (f32x4*)(outf + off + 4)); }
                    if (xb) { u32x4 w; w.x = cvt_pk_bf16(v0[0], v0[1]); w.y = cvt_pk_bf16(v0[2], v0[3]); w.z = cvt_pk_bf16(v1[0], v1[1]); w.w = cvt_pk_bf16(v1[2], v1[3]); *(u32x4*)(xb + off) = w; }
                    s += ((v0[0] * v0[0] + v0[1] * v0[1]) + (v0[2] * v0[2] + v0[3] * v0[3])) + ((v1[0] * v1[0] + v1[1] * v1[1]) + (v1[2] * v1[2] + v1[3] * v1[3]));
                }
                if (ssq_out) { s += __shfl_xor(s, 16); s += __shfl_xor(s, 32); if (fq == 0) ssq_out[(size_t)row * 16 + u.pn * 4 + wc] = s; }
            }
    }
};

struct EpiInProj {
    static constexpr bool PERM = true, AFTER_DRAIN = false;
    bf16_t* O; const float* ssq; const float* qn; const float* kn; const float* rsl; int pm_c;
    __device__ __forceinline__ void operator()(const f32x4 (&acc)[2][2][4][2], const Unit& u, int wr, int wc, int fr, int fq) const {
        const int row0 = u.pm * BM + wr * 64 + fr, col0 = u.pn * BM + wc * 64 + 8 * fq;
        const bool isq = (u.pn == 4 || u.pn == 5), isk = (u.pn == 6 || u.pn == 7), hn = isq || isk;
        f32x4 gn[2][2];
#pragma unroll
        for (int bj = 0; bj < 2; ++bj)
#pragma unroll
            for (int n = 0; n < 2; ++n) { gn[bj][n] = (f32x4){1.f, 1.f, 1.f, 1.f}; if (hn) gn[bj][n] = *(const f32x4*)((isq ? qn : kn) + 32 * bj + 8 * fq + 4 * n) * (isq ? 0.125f : 1.0f); }
        float rsv[2][4];
        if (u.pm == pm_c) {
#pragma unroll
            for (int ai = 0; ai < 2; ++ai)
#pragma unroll
                for (int m = 0; m < 4; ++m) rsv[ai][m] = rsl[ai * HALF + wr * 64 + m * 16 + fr];
        } else {
            asm volatile("" ::: "memory");
#pragma unroll
            for (int ai = 0; ai < 2; ++ai)
#pragma unroll
                for (int m = 0; m < 4; ++m) rsv[ai][m] = row_rs(ssq, row0 + ai * HALF + m * 16, fq, 1.0f / 1024.0f, 1e-6f);
        }
#pragma unroll
        for (int ai = 0; ai < 2; ++ai)
#pragma unroll
            for (int m = 0; m < 4; ++m) {
                const int row = row0 + ai * HALF + m * 16;
                const float rs = rsv[ai][m];
                f32x4 v[2][2]; float s = 0.f;
#pragma unroll
                for (int bj = 0; bj < 2; ++bj)
#pragma unroll
                    for (int n = 0; n < 2; ++n) { v[bj][n] = acc[ai][bj][m][n] * rs; const f32x4 t = v[bj][n]; s += (t[0] * t[0] + t[1] * t[1]) + (t[2] * t[2] + t[3] * t[3]); }
                if (hn) { s += __shfl_xor(s, 16); s += __shfl_xor(s, 32); const float rq = __builtin_amdgcn_rsqf(s * (1.0f / 64.0f) + 1e-6f);
#pragma unroll
                    for (int bj = 0; bj < 2; ++bj)
#pragma unroll
                        for (int n = 0; n < 2; ++n) v[bj][n] = v[bj][n] * rq * gn[bj][n]; }
#pragma unroll
                for (int bj = 0; bj < 2; ++bj) { u32x4 w; w.x = cvt_pk_bf16(v[bj][0][0], v[bj][0][1]); w.y = cvt_pk_bf16(v[bj][0][2], v[bj][0][3]); w.z = cvt_pk_bf16(v[bj][1][0], v[bj][1][1]); w.w = cvt_pk_bf16(v[bj][1][2], v[bj][1][3]);
                    *(u32x4*)(O + (size_t)row * 2560 + col0 + 32 * bj) = w; }
            }
    }
};

template <class Epi, class Sched, bool ALIGN_EPI = false, bool SP2 = false>
__device__ __forceinline__ void gemm_phase(PG8_LAS unsigned char* lds, const Gemm g, const Sched& S, const Epi& E) {
    const int tid = threadIdx.x, wid = __builtin_amdgcn_readfirstlane(tid >> 6), lane = tid & 63, wr = wid >> 2, wc = wid & 3, fr = lane & 15, fq = lane >> 4;
    const int K = g.K, nt = K / BK;
    unsigned voffA[2], voffB[2];
#pragma unroll
    for (int i = 0; i < 2; ++i) { int R, C; stage_rc(tid * 16 + i * 8192, R, C); const int Rb = Epi::PERM ? ((R & ~31) + perm32(R & 31)) : R;
        voffA[i] = (unsigned)(R * K + C) * 2u; voffB[i] = (unsigned)(Rb * K + C) * 2u; }
    const size_t kstep = (size_t)(BK * 2);
    const size_t hstep = (size_t)HALF * K * 2;
    const size_t tstep = 2 * hstep;
    const unsigned ldsw = (unsigned)wid * 1024u;
    const int aoff = lds_byte(wr * 64 + fr, fq * 8), boff = lds_byte(wc * 32 + fr, fq * 8);
#define PG8_SA(b, h) (((b) * 2 + (h)) * HTB)
#define PG8_SB(b, h) ((4 + (b) * 2 + (h)) * HTB)
#define PG8_STAGE(bufoff, gbase, voff) do { _Pragma("unroll") for (int _i = 0; _i < 2; ++_i) \
        __builtin_amdgcn_global_load_lds((const unsigned*)((const char*)(gbase) + (voff)[_i]), (PG8_LAS unsigned*)(lds + (bufoff) + ldsw + _i * 8192), 16, 0, 0); } while (0)
#define PG8_LDA(dst, b, h) do { _Pragma("unroll") for (int m = 0; m < 4; ++m) _Pragma("unroll") for (int k = 0; k < 2; ++k) dst[m][k] = *(const PG8_LAS bf16x8*)(lds + PG8_SA(b, h) + aoff + m * 2048 + k * 1024); } while (0)
#define PG8_LDB(dst, b, h) do { _Pragma("unroll") for (int n = 0; n < 2; ++n) _Pragma("unroll") for (int k = 0; k < 2; ++k) dst[n][k] = *(const PG8_LAS bf16x8*)(lds + PG8_SB(b, h) + boff + n * 2048 + k * 1024); } while (0)
#define PG8_MMA(ai, bj, At, Bt) do { __builtin_amdgcn_s_setprio(1); _Pragma("unroll") for (int m = 0; m < 4; ++m) _Pragma("unroll") for (int n = 0; n < 2; ++n) _Pragma("unroll") for (int k = 0; k < 2; ++k) \
        acc[ai][bj][m][n] = __builtin_amdgcn_mfma_f32_16x16x32_bf16(Bt[n][k], At[m][k], acc[ai][bj][m][n], 0, 0, 0); __builtin_amdgcn_s_setprio(0); } while (0)
#define PG8_WAIT_V(n) asm volatile("s_waitcnt vmcnt(" #n ")" ::: "memory")
#define PG8_WAIT_L(n) asm volatile("s_waitcnt lgkmcnt(" #n ")" ::: "memory")
#define PG8_BAR __builtin_amdgcn_s_barrier()
#define PG8_SCHED __builtin_amdgcn_sched_barrier(0)
    Unit cur, nxt; int ui = 0;
    if (!S.next(0, cur)) return;
    f32x4 acc[2][2][4][2];
#pragma unroll
    for (int a = 0; a < 2; ++a)
#pragma unroll
        for (int b = 0; b < 2; ++b)
#pragma unroll
            for (int m = 0; m < 4; ++m)
#pragma unroll
                for (int n = 0; n < 2; ++n) acc[a][b][m][n] = (f32x4){0.f, 0.f, 0.f, 0.f};
    bf16x8 At[4][2], B0[2][2], B1[2][2];
    const char* cA = (const char*)g.A + (size_t)cur.pm * tstep; const char* cB = (const char*)g.Bt + (size_t)cur.pn * tstep;
    S.a_ready(cur);
    if constexpr (SP2) {
        PG8_STAGE(PG8_SB(0, 0), cB, voffB); PG8_STAGE(PG8_SB(0, 1), cB + hstep, voffB); PG8_STAGE(PG8_SA(0, 0), cA, voffA); PG8_STAGE(PG8_SA(0, 1), cA + hstep, voffA);
        if (wr == 1) PG8_BAR;
        PG8_WAIT_V(2); PG8_BAR;
        PG8_STAGE(PG8_SB(1, 0), cB + kstep, voffB); PG8_STAGE(PG8_SA(1, 0), cA + kstep, voffA); PG8_STAGE(PG8_SB(1, 1), cB + hstep + kstep, voffB);
        PG8_WAIT_V(6); PG8_BAR;
    } else {
        PG8_STAGE(PG8_SB(0, 0), cB, voffB); PG8_STAGE(PG8_SA(0, 0), cA, voffA); PG8_STAGE(PG8_SB(0, 1), cB + hstep, voffB); PG8_STAGE(PG8_SA(0, 1), cA + hstep, voffA);
        if (wr == 1) PG8_BAR;
        PG8_WAIT_V(4); PG8_BAR;
        PG8_STAGE(PG8_SB(1, 0), cB + kstep, voffB); PG8_STAGE(PG8_SA(1, 0), cA + kstep, voffA); PG8_STAGE(PG8_SB(1, 1), cB + hstep + kstep, voffB);
        PG8_WAIT_V(6); PG8_BAR;
    }
    for (;;) {
        const bool has_next = S.next(ui + 1, nxt);
        const char* nA = has_next ? (const char*)g.A + (size_t)nxt.pm * tstep : cA; const char* nB = has_next ? (const char*)g.Bt + (size_t)nxt.pn * tstep : cB;
        for (int t = 0; t < nt; t += 2) {
            const bool last = (t == nt - 2);
            const char* a1 = cA + (size_t)(t + 1) * kstep;
            const char* a2 = last ? nA : cA + (size_t)(t + 2) * kstep; const char* b2 = last ? nB : cB + (size_t)(t + 2) * kstep;
            const char* a3 = a2 + kstep; const char* b3 = b2 + kstep;
            if (last && has_next) S.a_ready(nxt);
            if constexpr (SP2) {
            PG8_LDB(B0, 0, 0); PG8_LDB(B1, 0, 1); PG8_SCHED; PG8_LDA(At, 0, 0); PG8_STAGE(PG8_SA(1, 1), a1 + hstep, voffA);
            PG8_WAIT_V(8); PG8_WAIT_L(0); PG8_BAR; PG8_MMA(0, 0, At, B0); PG8_MMA(0, 1, At, B1); PG8_BAR; PG8_SCHED;
            PG8_LDA(At, 0, 1); PG8_STAGE(PG8_SB(0, 0), b2, voffB); PG8_STAGE(PG8_SB(0, 1), b2 + hstep, voffB); PG8_STAGE(PG8_SA(0, 0), a2, voffA);
            PG8_WAIT_V(8); PG8_WAIT_L(0); PG8_BAR; PG8_MMA(1, 0, At, B0); PG8_MMA(1, 1, At, B1); PG8_BAR; PG8_SCHED;
            PG8_LDB(B0, 1, 0); PG8_LDB(B1, 1, 1); PG8_SCHED; PG8_LDA(At, 1, 0); PG8_STAGE(PG8_SA(0, 1), a2 + hstep, voffA);
            PG8_WAIT_V(8); PG8_WAIT_L(0); PG8_BAR; PG8_MMA(0, 0, At, B0); PG8_MMA(0, 1, At, B1); PG8_BAR; PG8_SCHED;
            PG8_LDA(At, 1, 1); PG8_STAGE(PG8_SB(1, 0), b3, voffB); PG8_STAGE(PG8_SB(1, 1), b3 + hstep, voffB); PG8_STAGE(PG8_SA(1, 0), a3, voffA);
            PG8_WAIT_V(8); PG8_WAIT_L(0); PG8_BAR; PG8_MMA(1, 0, At, B0); PG8_MMA(1, 1, At, B1); PG8_BAR; PG8_SCHED;
            } else {
            PG8_LDB(B0, 0, 0); PG8_SCHED; PG8_LDA(At, 0, 0); PG8_STAGE(PG8_SA(1, 1), a1 + hstep, voffA);
            PG8_WAIT_L(8); PG8_BAR; PG8_WAIT_L(0); PG8_MMA(0, 0, At, B0); PG8_BAR; PG8_SCHED;
            PG8_LDB(B1, 0, 1); PG8_STAGE(PG8_SB(0, 0), b2, voffB);
            PG8_BAR; PG8_WAIT_L(0); PG8_MMA(0, 1, At, B1); PG8_BAR;
            PG8_LDA(At, 0, 1); PG8_STAGE(PG8_SA(0, 0), a2, voffA);
            PG8_BAR; PG8_WAIT_L(0); PG8_MMA(1, 0, At, B0); PG8_BAR; PG8_SCHED;
            PG8_STAGE(PG8_SB(0, 1), b2 + hstep, voffB);
            PG8_WAIT_V(6); PG8_BAR; PG8_MMA(1, 1, At, B1); PG8_BAR;
            PG8_LDB(B0, 1, 0); PG8_SCHED; PG8_LDA(At, 1, 0); PG8_STAGE(PG8_SA(0, 1), a2 + hstep, voffA);
            PG8_WAIT_L(8); PG8_BAR; PG8_WAIT_L(0); PG8_MMA(0, 0, At, B0); PG8_BAR; PG8_SCHED;
            PG8_LDB(B1, 1, 1); PG8_STAGE(PG8_SB(1, 0), b3, voffB);
            PG8_BAR; PG8_WAIT_L(0); PG8_MMA(0, 1, At, B1); PG8_BAR;
            PG8_LDA(At, 1, 1); PG8_STAGE(PG8_SA(1, 0), a3, voffA);
            PG8_BAR; PG8_WAIT_L(0); PG8_MMA(1, 0, At, B0); PG8_BAR; PG8_SCHED;
            PG8_STAGE(PG8_SB(1, 1), b3 + hstep, voffB);
            PG8_WAIT_V(6); PG8_BAR; PG8_MMA(1, 1, At, B1); PG8_BAR;
            }
        }
        if constexpr (ALIGN_EPI) { if (wr == 0) PG8_BAR; }
        if constexpr (!Epi::AFTER_DRAIN) { E(acc, cur, wr, wc, fr, fq); S.done(cur); }
        if (!has_next) break;
#pragma unroll
        for (int a = 0; a < 2; ++a)
#pragma unroll
            for (int b = 0; b < 2; ++b)
#pragma unroll
                for (int m = 0; m < 4; ++m)
#pragma unroll
                    for (int n = 0; n < 2; ++n) acc[a][b][m][n] = (f32x4){0.f, 0.f, 0.f, 0.f};
        cur = nxt; cA = nA; cB = nB; ++ui;
        if constexpr (ALIGN_EPI) { if (wr == 1) PG8_BAR; }
    }
    PG8_WAIT_V(0);
    if constexpr (!ALIGN_EPI) { if (wr == 0) PG8_BAR; }
    PG8_BAR;
    if constexpr (Epi::AFTER_DRAIN) { E.fused(acc, cur, wr, wc, fr, fq, lds, wid, lane); S.done(cur); }
#undef PG8_SA
#undef PG8_SB
#undef PG8_STAGE
#undef PG8_LDA
#undef PG8_LDB
#undef PG8_MMA
#undef PG8_WAIT_V
#undef PG8_WAIT_L
#undef PG8_BAR
#undef PG8_SCHED
}
}

#include <hip/hip_cooperative_groups.h>
namespace cg = cooperative_groups;
#ifndef DOUBLE_PHASE
#define DOUBLE_PHASE (-1)
#endif
#define REP(k) for (int rep_ = 0; rep_ < ((DOUBLE_PHASE) == (k) ? 2 : 1); ++rep_)
#ifndef MK_LAUNCHES
#define MK_LAUNCHES 1
#endif
typedef unsigned short bf16_t;
typedef float f32x4 __attribute__((ext_vector_type(4)));
typedef unsigned u32x4 __attribute__((ext_vector_type(4)));
typedef unsigned u32x2 __attribute__((ext_vector_type(2)));
constexpr int NWAVES = 8, NTHR = 512, N_PHASES = 9;
constexpr int T = 16384, SEQ = 4096, DM = 1024, DFF = 2816, NIN = 2560, DRNN = 512, NCHUNK = 64;
constexpr float EPS = 1e-6f;
constexpr size_t MiB = 1u << 20;
constexpr size_t WS_WIN = 0, WS_WOUT = 5 * MiB, WS_WGU2 = 7 * MiB, WS_WD2 = 18 * MiB, WS_SSQ = 24 * MiB, WS_SUM = 27 * MiB, WS_XB = 28 * MiB;
constexpr size_t WS_WGU1 = 60 * MiB, WS_WD1 = 71 * MiB, WS_ACT = 77 * MiB;
constexpr size_t WS_PROJ = 60 * MiB, WS_H = 140 * MiB, WS_P = 172 * MiB, WS_Y = 204 * MiB, WS_BAR = 236 * MiB, WS_END = 237 * MiB;
constexpr size_t WS_WPK = WS_BAR + 512 * 1024;
constexpr size_t WS_GRAN = 237 * MiB, WS_END2 = 239 * MiB;
constexpr size_t BAR_ZERO_BYTES = 16384;
static_assert(WS_WD2 + (size_t)DM * DFF * 2 <= WS_SSQ && WS_ACT + (size_t)T * DFF * 2 <= WS_Y && WS_PROJ + (size_t)T * NIN * 2 <= WS_H, "d_ws map");
constexpr int LDS_CTL_OFF = 131072, LDS_RS_OFF = 131072 + 256, LDS_BYTES = 131072 + 256 + 1024;

__device__ __forceinline__ float bf_lo(unsigned u) { return __uint_as_float(u << 16); }
__device__ __forceinline__ float bf_hi(unsigned u) { return __uint_as_float(u & 0xffff0000u); }
__device__ __forceinline__ float bf_1(bf16_t u) { return __uint_as_float((unsigned)u << 16); }
__device__ __forceinline__ unsigned pk_bf16(float lo, float hi) { return pg8::cvt_pk_bf16(lo, hi); }
__device__ __forceinline__ float wave_sum(float v) {
#pragma unroll
    for (int o = 1; o < 64; o <<= 1) v += __shfl_xor(v, o);
    return v;
}
__device__ __forceinline__ float gelu_tanh(float x) {
    const float u = 0.7978845608028654f * (x + 0.044715f * x * x * x);
    const float t = 1.0f - 2.0f * __builtin_amdgcn_rcpf(1.0f + __builtin_amdgcn_exp2f(2.0f * 1.4426950408889634f * u));
    return 0.5f * x * (1.0f + t);
}

#define GAS __attribute__((address_space(1)))
#define LAS __attribute__((address_space(3)))
typedef GAS unsigned gu32;
typedef GAS unsigned long long gu64;
#define RLX_AGENT __ATOMIC_RELAXED, __HIP_MEMORY_SCOPE_AGENT
#define LDS_WAIT() asm volatile("s_waitcnt lgkmcnt(0)" ::: "memory")
#define VM_WAIT() asm volatile("s_waitcnt vmcnt(0)" ::: "memory")
__device__ __forceinline__ unsigned long long rt() { return __builtin_amdgcn_s_memrealtime(); }
#define XB_TMO      128
#define XB_XCNT(j)  (256  + 64 * (j))
#define XB_XSUB(j)  (1280 + 64 * (j))
#define XB_XGEN(j)  (2304 + 64 * (j))
#define XB_TOP      3328
#define XB_TOPGEN   3392
#define XCD_BAR_WORDS 3456
#define XB_SPIN_CAP (1u << 18)

__device__ __forceinline__ unsigned xb_ld(unsigned* p)              { return __hip_atomic_load(p, __ATOMIC_RELAXED, __HIP_MEMORY_SCOPE_AGENT); }
__device__ __forceinline__ unsigned xb_add(unsigned* p, unsigned v) { return __hip_atomic_fetch_add(p, v, __ATOMIC_RELAXED, __HIP_MEMORY_SCOPE_AGENT); }
__device__ __forceinline__ unsigned xb_xcc_id() { return (unsigned)__builtin_amdgcn_s_getreg((3 << 11) | 20) & 0xFu; }
#define XB_SPIN(cond, bar) do { unsigned _sp = 0; while (cond) { __builtin_amdgcn_s_sleep(1); \
    if ((++_sp & 255u) == 0u) { if (xb_ld(&(bar)[XB_TMO])) break; if (_sp > XB_SPIN_CAP) { atomicAdd(&(bar)[XB_TMO], 1u); break; } } } } while (0)

struct XcdBarrier {
    unsigned* bar; unsigned x;
    volatile LAS unsigned* st;
};

__device__ __forceinline__ XcdBarrier xcd_barrier_post(unsigned* bar, volatile LAS unsigned* st) {
    XcdBarrier b; b.bar = bar; b.x = xb_xcc_id(); b.st = st;
    if (threadIdx.x == 0) (void)xb_add(&bar[XB_XCNT(b.x)], 1u);
    return b;
}
__device__ __forceinline__ void xcd_barrier_complete(unsigned* bar, unsigned x, unsigned& nloc, unsigned& nx) {
    const unsigned G = gridDim.x * gridDim.y * gridDim.z;
    unsigned sum, cnt, mine, sp = 0u;
    for (;;) {
        sum = 0u; cnt = 0u; mine = 0u;
#pragma unroll
        for (unsigned j = 0; j < 16; ++j) { const unsigned c = xb_ld(&bar[XB_XCNT(j)]); sum += c; cnt += (c > 0u) ? 1u : 0u; mine = (j == x) ? c : mine; }
        if (sum == G) break;
        __builtin_amdgcn_s_sleep(1);
        if ((++sp & 255u) == 0u) { if (xb_ld(&bar[XB_TMO])) break; if (sp > XB_SPIN_CAP) { atomicAdd(&bar[XB_TMO], 1u); break; } }
    }
    nloc = mine > 0u ? mine : 1u; nx = cnt > 0u ? cnt : 1u;
}

__device__ __forceinline__ void xcd_barrier(const XcdBarrier& b) {
    asm volatile("s_waitcnt vmcnt(0)" ::: "memory");
    __syncthreads();
    if (threadIdx.x == 0) {
        unsigned* bar = b.bar;
        __builtin_amdgcn_s_waitcnt(0);
        unsigned nloc = b.st[0], nx = b.st[1];
        if (nloc == 0u) { xcd_barrier_complete(bar, b.x, nloc, nx); b.st[0] = nloc; b.st[1] = nx; }
        const unsigned old = xb_add(&bar[XB_XSUB(b.x)], 1u);
        const unsigned gen = old / nloc;
        if (old + 1u == (gen + 1u) * nloc) {
            __builtin_amdgcn_fence(__ATOMIC_RELEASE, "agent");
            asm volatile("s_waitcnt vmcnt(0)" ::: "memory");
            const unsigned og = xb_add(&bar[XB_TOP], 1u);
            const unsigned tg = og / nx;
            if (og + 1u == (tg + 1u) * nx) xb_add(&bar[XB_TOPGEN], 1u);
            else XB_SPIN(xb_ld(&bar[XB_TOPGEN]) == tg, bar);
            __builtin_amdgcn_fence(__ATOMIC_ACQUIRE, "agent");
            xb_add(&bar[XB_XGEN(b.x)], 1u);
            asm volatile("s_waitcnt vmcnt(0)" ::: "memory");
        } else {
            XB_SPIN(xb_ld(&bar[XB_XGEN(b.x)]) == gen, bar);
            __builtin_amdgcn_fence(__ATOMIC_ACQUIRE, "agent");
            asm volatile("s_waitcnt vmcnt(0)" ::: "memory");
        }
    }
    __syncthreads();
}


struct Args { const float* in[23]; float* out; unsigned char* ws; int ph_lo, ph_hi; };
enum { I_X = 0, I_N1, I_G1, I_U1, I_D1, I_MN, I_WIN, I_CW, I_CB, I_WA, I_BA, I_WX, I_BX, I_LAM, I_QN, I_KN, I_RON, I_AON, I_WOUT, I_N2, I_G2, I_U2, I_D2 };

__device__ __forceinline__ void transpose_item(const float* W, int K, int N, const float* gk, bf16_t* WT, int dst_row0, float* scr, int k0, int n0, int lane) {
    float wv[32];
#pragma unroll
    for (int i = 0; i < 32; ++i) wv[i] = __builtin_nontemporal_load(W + (size_t)(k0 + 2 * i + (lane >> 5)) * N + n0 + (lane & 31));
    if (gk) {
#pragma unroll
        for (int i = 0; i < 32; ++i) wv[i] *= gk[k0 + 2 * i + (lane >> 5)]; }
#pragma unroll
    for (int i = 0; i < 32; ++i) scr[(2 * i + (lane >> 5)) * 33 + (lane & 31)] = wv[i];
    asm volatile("s_waitcnt lgkmcnt(0)" ::: "memory");
    const int c = lane & 7;
#pragma unroll
    for (int j = 0; j < 4; ++j) { const int n = (lane >> 3) + 8 * j; const float* s = scr + (8 * c) * 33 + n;
        u32x4 o; o.x = pk_bf16(s[0 * 33], s[1 * 33]); o.y = pk_bf16(s[2 * 33], s[3 * 33]); o.z = pk_bf16(s[4 * 33], s[5 * 33]); o.w = pk_bf16(s[6 * 33], s[7 * 33]);
        *(u32x4*)(WT + (size_t)(dst_row0 + n) * K + k0 + 8 * c) = o; }
    asm volatile("s_waitcnt lgkmcnt(0)" ::: "memory");
}
constexpr int CV_F = (DM / 64) * (DFF / 32), CV_IN = (DM / 64) * (NIN / 32), CV_O = (DM / 64) * (DM / 32);
constexpr int CV_P0_END = 2 * CV_F, CV_A_END = 3 * CV_F, CV_B_END = CV_A_END + CV_IN + CV_O + CV_F, CV_END = CV_B_END + 2 * CV_F;
__device__ __forceinline__ void convert_item(const Args& a, float* scr, int id, int lane) {
    unsigned char* ws = a.ws; int r = id;
    if (r < 2 * CV_F || r >= CV_B_END) {
        const int ffn = r >= CV_B_END; if (ffn) r -= CV_B_END; const int up = r / CV_F; r -= up * CV_F;
        const float* W = a.in[ffn ? (up ? I_U2 : I_G2) : (up ? I_U1 : I_G1)]; const float* g = a.in[ffn ? I_N2 : I_N1];
        bf16_t* WT = (bf16_t*)(ws + (ffn ? WS_WGU2 : WS_WGU1));
        const int nblk = DFF / 32, kb = r / nblk, nb = r % nblk, n0 = 32 * nb;
        transpose_item(W, DM, DFF, g, WT, 256 * (n0 / 128) + 128 * up + (n0 % 128), scr, 64 * kb, n0, lane); return; }
    if (r < CV_A_END || r >= CV_A_END + CV_IN + CV_O) {
        const int ffn = r >= CV_A_END; r -= ffn ? (CV_A_END + CV_IN + CV_O) : 2 * CV_F;
        const int nblk = DM / 32, kb = r / nblk, nb = r % nblk, n0 = 32 * nb;
        transpose_item(a.in[ffn ? I_D2 : I_D1], DFF, DM, nullptr, (bf16_t*)(ws + (ffn ? WS_WD2 : WS_WD1)), n0, scr, 64 * kb, n0, lane); return; }
    r -= CV_A_END;
    if (r < CV_IN) {
        const int nblk = NIN / 32, kb = r / nblk, nb = r % nblk, n0 = 32 * nb, o = n0 % 256, wc = o / 64, bj = (o % 64) / 32;
        transpose_item(a.in[I_WIN], DM, NIN, a.in[I_MN], (bf16_t*)(ws + WS_WIN), (n0 - o) + 128 * bj + 32 * wc, scr, 64 * kb, n0, lane); return; }
    r -= CV_IN;
    { const int nblk = DM / 32, kb = r / nblk, nb = r % nblk, n0 = 32 * nb;
      transpose_item(a.in[I_WOUT], DM, DM, nullptr, (bf16_t*)(ws + WS_WOUT), n0, scr, 64 * kb, n0, lane); }
}
__device__ __forceinline__ void convert_range(const Args& a, unsigned char* lds, int first, int last, int w, int NW, int wave, int lane) {
    float* scr = (float*)(lds + wave * 16384);
    for (int id = first + w; id < last; id += NW) convert_item(a, scr, id, lane);
}
__device__ __forceinline__ void phase_prologue(const Args& a, unsigned char* lds, int gw, int NGW, int wave, int lane, bool split) {
    unsigned char* ws = a.ws;
    convert_range(a, lds, 0, split ? CV_P0_END : CV_END, gw, NGW, wave, lane);
    const float* x = a.in[I_X]; bf16_t* xb = (bf16_t*)(ws + WS_XB); float* ssq = (float*)(ws + WS_SSQ);
    const int rbase = split ? 2048 * ((gw >> 3) & 7) + 64 * (gw >> 6) + (gw & 7) : gw, rstep = split ? 8 : NGW, rend = split ? rbase + 64 : T;
    for (int m0 = rbase; m0 < rend; m0 += 8 * rstep) {
        f32x4 v[8][4]; float sq[8];
#pragma unroll
        for (int q = 0; q < 8; ++q) { const int m = (m0 + q * rstep < rend) ? m0 + q * rstep : m0; const f32x4* xr = (const f32x4*)(x + (size_t)m * DM) + lane;
#pragma unroll
            for (int j = 0; j < 4; ++j) v[q][j] = __builtin_nontemporal_load(xr + 64 * j); }
#pragma unroll
        for (int q = 0; q < 8; ++q) { float t = 0.f;
#pragma unroll
            for (int j = 0; j < 4; ++j) t += (v[q][j][0] * v[q][j][0] + v[q][j][1] * v[q][j][1]) + (v[q][j][2] * v[q][j][2] + v[q][j][3] * v[q][j][3]);
            sq[q] = wave_sum(t); }
#pragma unroll
        for (int q = 0; q < 8; ++q) { const int m = m0 + q * rstep; if (m < rend) { u32x2* o = (u32x2*)(xb + (size_t)m * DM) + lane;
#pragma unroll
            for (int j = 0; j < 4; ++j) { u32x2 w; w.x = pk_bf16(v[q][j][0], v[q][j][1]); w.y = pk_bf16(v[q][j][2], v[q][j][3]); o[64 * j] = w; }
            if (lane < 16) ssq[(size_t)m * 16 + lane] = (lane == 0) ? sq[q] : 0.f; } }
    }
    { unsigned long long* gr = (unsigned long long*)(ws + WS_GRAN); for (int i = gw * 64 + lane; i < 4 * NCHUNK * DRNN; i += NGW * 64) gr[i] = 0ull; }
    for (int idx = gw * 64 + lane; idx < 2 * 8 * 2 * 4 * 64; idx += NGW * 64) {
        const int l = idx & 63, ks = (idx >> 6) & 3, half = (idx >> 8) & 1, n = (idx >> 9) & 7, mat = idx >> 12;
        const float* w = a.in[mat ? I_WX : I_WA] + (size_t)(n * 64 + 16 * ks + 8 * (l >> 5)) * 64 + 32 * half + (l & 31);
        u32x4 pkd; pkd.x = pk_bf16(w[0], w[64]); pkd.y = pk_bf16(w[128], w[192]); pkd.z = pk_bf16(w[256], w[320]); pkd.w = pk_bf16(w[384], w[448]);
        ((u32x4*)(ws + WS_WPK))[idx] = pkd;
    }
}

typedef short bf16x8_t __attribute__((ext_vector_type(8)));
typedef float f32x16 __attribute__((ext_vector_type(16)));
__device__ __forceinline__ int crow(int r, int hi) { return (r & 3) + 8 * (r >> 2) + 4 * hi; }
__device__ __forceinline__ float sigmoid_fast(float x) { return __builtin_amdgcn_rcpf(1.0f + __builtin_amdgcn_exp2f(-1.4426950408889634f * x)); }
__device__ __forceinline__ void rnn_item(const Args& a, int item, unsigned char* wl, int lane) {
    constexpr int XP = 144;
    const int b = item >> 9, n = (item >> 6) & 7, c = item & 63, ql = lane & 31, hi = lane >> 5;
    unsigned char* ws = a.ws;
    const bf16_t* PROJ = (const bf16_t*)(ws + WS_PROJ); unsigned* HPg = (unsigned*)(ws + WS_H);
    const size_t row0 = (size_t)b * SEQ + (size_t)c * 64;
    u32x4 wfr[2][2][4];
#pragma unroll
    for (int mat = 0; mat < 2; ++mat)
#pragma unroll
        for (int hf = 0; hf < 2; ++hf)
#pragma unroll
            for (int ks = 0; ks < 4; ++ks) wfr[mat][hf][ks] = ((const u32x4*)(ws + WS_WPK))[(((mat * 8 + n) * 2 + hf) * 4 + ks) * 64 + lane];
    {
        const int ch = n * 64 + lane;
        const float cw0 = a.in[I_CW][ch], cw1 = a.in[I_CW][512 + ch], cw2 = a.in[I_CW][1024 + ch], cw3 = a.in[I_CW][1536 + ch], cb = a.in[I_CB][ch];
        const bf16_t* xp = PROJ + row0 * NIN + ch;
        float xm3 = 0.f, xm2 = 0.f, xm1 = 0.f;
        if (c > 0) { xm3 = bf_1(xp[-3 * NIN]); xm2 = bf_1(xp[-2 * NIN]); xm1 = bf_1(xp[-1 * NIN]); }
        bf16_t xv[64];
#pragma unroll
        for (int t = 0; t < 64; ++t) xv[t] = xp[(size_t)t * NIN];
#pragma unroll
        for (int t = 0; t < 64; ++t) { const float x0 = bf_1(xv[t]); const float xc = cb + cw0 * xm3 + cw1 * xm2 + cw2 * xm1 + cw3 * x0;
            ((bf16_t*)(wl + t * XP))[lane] = (bf16_t)(pk_bf16(xc, xc) & 0xffffu); xm3 = xm2; xm2 = xm1; xm1 = x0; }
    }
    asm volatile("s_waitcnt lgkmcnt(0)" ::: "memory");
#pragma unroll
    for (int dblk = 0; dblk < 2; ++dblk) {
        const int d = 32 * dblk + ql, ch = n * 64 + d;
        bf16x8_t bfa[4], bfx[4];
#pragma unroll
        for (int ks = 0; ks < 4; ++ks) { bfa[ks] = __builtin_bit_cast(bf16x8_t, wfr[0][dblk][ks]); bfx[ks] = __builtin_bit_cast(bf16x8_t, wfr[1][dblk][ks]); }
        const float ba = a.in[I_BA][ch], bx = a.in[I_BX][ch], lam = a.in[I_LAM][ch];
        const float lsl8 = -8.0f * (fmaxf(-lam, 0.f) + log1pf(expf(-fabsf(lam))));
        float cH = 0.f, cP = 1.f;
#pragma unroll
        for (int tb = 0; tb < 2; ++tb) {
            f32x16 R, I;
#pragma unroll
            for (int r = 0; r < 16; ++r) { R[r] = 0.f; I[r] = 0.f; }
#pragma unroll
            for (int ks = 0; ks < 4; ++ks) { const bf16x8_t af = *(const bf16x8_t*)(wl + (32 * tb + ql) * XP + (16 * ks + 8 * hi) * 2);
                R = __builtin_amdgcn_mfma_f32_32x32x16_bf16(af, bfa[ks], R, 0, 0, 0); I = __builtin_amdgcn_mfma_f32_32x32x16_bf16(af, bfx[ks], I, 0, 0, 0); }
            float xcl[16];
#pragma unroll
            for (int r = 0; r < 16; ++r) xcl[r] = bf_1(((const bf16_t*)(wl + (32 * tb + crow(r, hi)) * XP))[d]);
            float Hl[16], Pl[16], Ar[4], Br[4];
#pragma unroll
            for (int g = 0; g < 4; ++g) {
                float H = 0.f, P = 1.f;
#pragma unroll
                for (int e = 0; e < 4; ++e) {
                    const int r = 4 * g + e, t = 32 * tb + crow(r, hi);
                    const float rg = sigmoid_fast(R[r] + ba), ig = sigmoid_fast(I[r] + bx);
                    const float la = rg * lsl8, av = __builtin_amdgcn_exp2f(1.4426950408889634f * la);
                    const float m2 = (1.0f - av) * (1.0f + av);
                    const float xcv = xcl[r];
                    const float bv = __builtin_amdgcn_sqrtf(m2) * (ig * xcv);
                    H = av * H + bv; P *= av; Hl[r] = H; Pl[r] = P;
                }
                Ar[g] = P; Br[g] = H;
            }
            float myH[4], myP[4];
#pragma unroll
            for (int g = 0; g < 4; ++g) {
                const float pA = __shfl_xor(Ar[g], 32), pB = __shfl_xor(Br[g], 32);
                const float A0 = hi ? pA : Ar[g], B0 = hi ? pB : Br[g], A1 = hi ? Ar[g] : pA, B1 = hi ? Br[g] : pB;
                const float eH = cH, eP = cP;
                cH = A0 * cH + B0; cP = A0 * cP;
                myH[g] = hi ? cH : eH; myP[g] = hi ? cP : eP;
                cH = A1 * cH + B1; cP = A1 * cP;
            }
#pragma unroll
            for (int r = 0; r < 16; ++r) {
                const unsigned o = ((unsigned)row0 + 32 * tb + crow(r, hi)) * DRNN + ch;
                HPg[o] = pk_bf16(Hl[r] + Pl[r] * myH[r >> 2], Pl[r] * myP[r >> 2]);
            }
        }
        if (hi == 0) {
            __hip_atomic_store((gu64*)(ws + WS_GRAN) + (size_t)(b * NCHUNK + c) * DRNN + ch, ((unsigned long long)__float_as_uint(cH) << 32) | (unsigned long long)(__float_as_uint(cP) | 1u), RLX_AGENT); }
    }
    asm volatile("s_waitcnt lgkmcnt(0)" ::: "memory");
}

typedef short s16x4_t __attribute__((ext_vector_type(4)));
typedef __attribute__((address_space(3))) s16x4_t* lds_s16x4_ptr;
constexpr int VPITCH = 192;
#define ATT_LOADK(KQ, tile) do { const int t_ = (tile) > 0 ? (tile) : 0; \
        _Pragma("unroll") for (int i = 0; i < 4; ++i) KQ[i] = *(const u32x4*)(kbase + (size_t)(t_ * 32 + (lane >> 3) + 8 * i) * NIN); } while (0)
#define ATT_LOADV(VV, tile) do { const int t_ = (tile) > 0 ? (tile) : 0; \
        _Pragma("unroll") for (int i = 0; i < 4; ++i) VV[i] = *(const u32x4*)(vbase + (size_t)(t_ * 32 + (lane >> 3) + 8 * i) * NIN); } while (0)
constexpr int KPITCH = 144, KLDS_OFF = 32 * VPITCH;
struct AttnPre { bf16x8_t qf[4]; u32x4 kq[4], kq1[4], vv[4], vn[4]; };
__device__ __forceinline__ void attn_fetch(const bf16_t* PROJ, int item, int lane, AttnPre& P) {
    const int b = item >> 10, h = (item >> 7) & 7, qt = item & 127, ql = lane & 31, hi = lane >> 5;
    const size_t rowb = (size_t)b * SEQ;
    const bf16_t* qrow = PROJ + (rowb + qt * 32 + ql) * NIN + 1024 + h * 64;
    const bf16_t* kbase = PROJ + rowb * NIN + 1536 + h * 64 + 8 * (lane & 7);
    const bf16_t* vbase = PROJ + rowb * NIN + 2048 + h * 64 + 8 * (lane & 7);
#pragma unroll
    for (int d0 = 0; d0 < 4; ++d0) P.qf[d0] = *(const bf16x8_t*)(qrow + 16 * d0 + 8 * hi);
    ATT_LOADK(P.kq, qt); ATT_LOADV(P.vv, qt); ATT_LOADK(P.kq1, qt - 1); ATT_LOADV(P.vn, qt - 1);
}
__device__ __forceinline__ void attn_wave(const Args& a, int first, int stride, int end, unsigned char* vlds, int lane) {
  if (first >= end) return;
  bf16_t* PROJ = (bf16_t*)(a.ws + WS_PROJ);
  AttnPre P; attn_fetch(PROJ, first, lane, P);
  for (int item = first;;) {
    const int b = item >> 10, h = (item >> 7) & 7, qt = item & 127;
    const size_t rowb = (size_t)b * SEQ; const int ql = lane & 31, hi = lane >> 5;
    bf16x8_t qf[4], kf[4]; u32x4 kq[4], vv[4], vn[4];
    unsigned char* kst = vlds + KLDS_OFF + (lane >> 3) * KPITCH + 16 * (lane & 7);
    const unsigned char* kfr = vlds + KLDS_OFF + ql * KPITCH + 16 * hi;
#pragma unroll
    for (int i = 0; i < 4; ++i) { qf[i] = P.qf[i]; vv[i] = P.vv[i]; vn[i] = P.vn[i]; *(u32x4*)(kst + 8 * i * KPITCH) = P.kq[i]; kq[i] = P.kq1[i]; }
#pragma unroll
    for (int d0 = 0; d0 < 4; ++d0) kf[d0] = *(const bf16x8_t*)(kfr + 32 * d0);
    f32x16 o0, o1;
#pragma unroll
    for (int r = 0; r < 16; ++r) { o0[r] = 0.f; o1[r] = 0.f; }
    float C = 0.f;
    const bf16_t* kbase = PROJ + rowb * NIN + 1536 + h * 64 + 8 * (lane & 7);
    const bf16_t* vbase = PROJ + rowb * NIN + 2048 + h * 64 + 8 * (lane & 7);
    unsigned char* vst = vlds + (lane >> 3) * VPITCH + 16 * (lane & 7);
    const lds_s16x4_ptr vtr0 = (lds_s16x4_ptr)(__attribute__((address_space(3))) unsigned char*)(vlds + (4 * hi + ((lane & 15) >> 2)) * VPITCH + (16 * ((lane >> 4) & 1) + 4 * (lane & 3)) * 2);
    for (int kt = qt; kt >= 0; --kt) {
        f32x16 p;
#pragma unroll
        for (int r = 0; r < 16; ++r) p[r] = 0.f;
#pragma unroll
        for (int d0 = 0; d0 < 4; ++d0) p = __builtin_amdgcn_mfma_f32_32x32x16_bf16(kf[d0], qf[d0], p, 0, 0, 0);
#pragma unroll
        for (int i = 0; i < 4; ++i) { *(u32x4*)(vst + 8 * i * VPITCH) = vv[i]; *(u32x4*)(kst + 8 * i * KPITCH) = kq[i]; vv[i] = vn[i]; }
        ATT_LOADK(kq, kt - 2); ATT_LOADV(vn, kt - 2);
        const bool diag = (kt == qt);
        float be[16], om[16];
#pragma unroll
        for (int r = 0; r < 16; ++r) {
            const float z = p[r];
            const float e = __builtin_amdgcn_exp2f(-1.4426950408889634f * __builtin_fabsf(z)), rc = __builtin_amdgcn_rcpf(1.0f + e), er = e * rc;
            const bool pos = z >= 0.f;
            be[r] = pos ? rc : er; om[r] = pos ? er : rc;
        }
        if (diag) {
#pragma unroll
            for (int r = 0; r < 16; ++r) { const bool act = crow(r, hi) < ql; be[r] = act ? be[r] : 0.f; om[r] = act ? om[r] : 1.0f; }
        }
        float s2[4], s1[4], s0[4], t[4], u[4];
#pragma unroll
        for (int g = 0; g < 4; ++g) { s2[g] = om[4 * g + 3]; s1[g] = s2[g] * om[4 * g + 2]; s0[g] = s1[g] * om[4 * g + 1]; const float G = s0[g] * om[4 * g]; t[g] = __shfl_xor(G, 32); u[g] = G * t[g]; }
        float U[4]; U[3] = 1.0f; U[2] = u[3]; U[1] = u[3] * u[2]; U[0] = U[1] * u[1];
        const float total = U[0] * u[0];
        const float eC = __builtin_amdgcn_exp2f(1.4426950408889634f * C);
        float w[16];
#pragma unroll
        for (int g = 0; g < 4; ++g) {
            const float base = eC * U[g] * (hi == 0 ? t[g] : 1.0f);
            w[4 * g + 3] = be[4 * g + 3] * base; w[4 * g + 2] = be[4 * g + 2] * (s2[g] * base); w[4 * g + 1] = be[4 * g + 1] * (s1[g] * base); w[4 * g] = be[4 * g] * (s0[g] * base);
        }
        C += 0.6931471805599453f * __builtin_amdgcn_logf(total);
        u32x4 wp0, wp1;
        wp0.x = pk_bf16(w[0], w[1]); wp0.y = pk_bf16(w[2], w[3]); wp0.z = pk_bf16(w[4], w[5]); wp0.w = pk_bf16(w[6], w[7]);
        wp1.x = pk_bf16(w[8], w[9]); wp1.y = pk_bf16(w[10], w[11]); wp1.z = pk_bf16(w[12], w[13]); wp1.w = pk_bf16(w[14], w[15]);
        const bf16x8_t wf0 = __builtin_bit_cast(bf16x8_t, wp0), wf1 = __builtin_bit_cast(bf16x8_t, wp1);
        asm volatile("s_waitcnt lgkmcnt(0)" ::: "memory");
#pragma unroll
        for (int dblk = 0; dblk < 2; ++dblk)
#pragma unroll
            for (int ks = 0; ks < 2; ++ks) {
                const s16x4_t lo = __builtin_bit_cast(s16x4_t, __builtin_amdgcn_ds_read_tr16_b64_v4i16((lds_s16x4_ptr)((__attribute__((address_space(3))) unsigned char*)vtr0 + (16 * ks) * VPITCH + 64 * dblk)));
                const s16x4_t hh = __builtin_bit_cast(s16x4_t, __builtin_amdgcn_ds_read_tr16_b64_v4i16((lds_s16x4_ptr)((__attribute__((address_space(3))) unsigned char*)vtr0 + (16 * ks + 8) * VPITCH + 64 * dblk)));
                const bf16x8_t vf = (bf16x8_t){lo[0], lo[1], lo[2], lo[3], hh[0], hh[1], hh[2], hh[3]};
                if (dblk == 0) o0 = __builtin_amdgcn_mfma_f32_32x32x16_bf16(vf, ks ? wf1 : wf0, o0, 0, 0, 0);
                else           o1 = __builtin_amdgcn_mfma_f32_32x32x16_bf16(vf, ks ? wf1 : wf0, o1, 0, 0, 0);
            }
        asm volatile("s_waitcnt lgkmcnt(0)" ::: "memory");
#pragma unroll
        for (int d0 = 0; d0 < 4; ++d0) kf[d0] = *(const bf16x8_t*)(kfr + 32 * d0);
        if (__all(C < -104.0f)) break;
    }
    const int nxt = item + stride; const bool more = nxt < end;
    if (more) attn_fetch(PROJ, nxt, lane, P);
    bf16_t* yrow = (bf16_t*)(a.ws + WS_Y) + (rowb + qt * 32 + ql) * DM + 512 + h * 64;
#pragma unroll
    for (int g = 0; g < 4; ++g) {
        u32x2 w0, w1; w0.x = pk_bf16(o0[4 * g], o0[4 * g + 1]); w0.y = pk_bf16(o0[4 * g + 2], o0[4 * g + 3]); w1.x = pk_bf16(o1[4 * g], o1[4 * g + 1]); w1.y = pk_bf16(o1[4 * g + 2], o1[4 * g + 3]);
        *(u32x2*)(yrow + 8 * g + 4 * hi) = w0; *(u32x2*)(yrow + 32 + 8 * g + 4 * hi) = w1;
    }
    if (!more) break;
    item = nxt;
  }
}

#undef ATT_LOADK
#undef ATT_LOADV
__device__ __forceinline__ void finalize_unit(const Args& a, int unit, float* carry, int tid, int wave, int lane) {
    const int b = unit >> 6, c = unit & 63;
    unsigned char* ws = a.ws;
    const bf16_t* PROJ = (const bf16_t*)(ws + WS_PROJ); const unsigned* HP = (const unsigned*)(ws + WS_H);
    bf16_t* Y = (bf16_t*)(ws + WS_Y);
    { float cr = 0.f;
      gu64* gp = (gu64*)(ws + WS_GRAN) + (size_t)(b * NCHUNK) * DRNN + tid;
      for (int c0 = 0; c0 < c; c0 += 32) {
          unsigned long long x[32];
          for (unsigned spins = 0;; ++spins) {
              bool ok = true;
#pragma unroll
              for (int k = 0; k < 32; ++k) { x[k] = ((c0 + k) < c) ? __hip_atomic_load(gp + (size_t)(c0 + k) * DRNN, RLX_AGENT) : 1ull; ok = ok && ((x[k] & 1ull) != 0ull); }
              if (ok || spins > (1u << 16)) break;
              __builtin_amdgcn_s_sleep(4);
          }
#pragma unroll
          for (int k = 0; k < 32; ++k) if ((c0 + k) < c) cr = __uint_as_float((unsigned)x[k]) * cr + __uint_as_float((unsigned)(x[k] >> 32));
      }
      carry[tid] = cr; }
    __syncthreads();
    const f32x4 c0 = *(const f32x4*)(carry + 8 * lane), c1 = *(const f32x4*)(carry + 8 * lane + 4);
    const f32x4 gr0 = *(const f32x4*)(a.in[I_RON] + 8 * lane), gr1 = *(const f32x4*)(a.in[I_RON] + 8 * lane + 4);
    const f32x4 ga0 = *(const f32x4*)(a.in[I_AON] + 8 * lane), ga1 = *(const f32x4*)(a.in[I_AON] + 8 * lane + 4);
#pragma unroll
    for (int i = 0; i < 8; ++i) {
        const size_t row = (size_t)b * SEQ + (size_t)c * 64 + wave * 8 + i;
        const u32x4 hp0 = __builtin_nontemporal_load((const u32x4*)(HP + row * DRNN + 8 * lane)), hp1 = __builtin_nontemporal_load((const u32x4*)(HP + row * DRNN + 8 * lane + 4));
        const u32x4 gt = __builtin_nontemporal_load((const u32x4*)(PROJ + row * NIN + 512 + 8 * lane));
        const u32x4 ya = __builtin_nontemporal_load((const u32x4*)(Y + row * DM + 512 + 8 * lane));
        float y[8], z[8];
        y[0] = (bf_lo(hp0.x) + bf_hi(hp0.x) * c0[0]) * gelu_tanh(bf_lo(gt.x)); y[1] = (bf_lo(hp0.y) + bf_hi(hp0.y) * c0[1]) * gelu_tanh(bf_hi(gt.x));
        y[2] = (bf_lo(hp0.z) + bf_hi(hp0.z) * c0[2]) * gelu_tanh(bf_lo(gt.y)); y[3] = (bf_lo(hp0.w) + bf_hi(hp0.w) * c0[3]) * gelu_tanh(bf_hi(gt.y));
        y[4] = (bf_lo(hp1.x) + bf_hi(hp1.x) * c1[0]) * gelu_tanh(bf_lo(gt.z)); y[5] = (bf_lo(hp1.y) + bf_hi(hp1.y) * c1[1]) * gelu_tanh(bf_hi(gt.z));
        y[6] = (bf_lo(hp1.z) + bf_hi(hp1.z) * c1[2]) * gelu_tanh(bf_lo(gt.w)); y[7] = (bf_lo(hp1.w) + bf_hi(hp1.w) * c1[3]) * gelu_tanh(bf_hi(gt.w));
        z[0] = bf_lo(ya.x); z[1] = bf_hi(ya.x); z[2] = bf_lo(ya.y); z[3] = bf_hi(ya.y); z[4] = bf_lo(ya.z); z[5] = bf_hi(ya.z); z[6] = bf_lo(ya.w); z[7] = bf_hi(ya.w);
        float sy = 0.f, sz = 0.f;
#pragma unroll
        for (int e = 0; e < 8; ++e) { sy += y[e] * y[e]; sz += z[e] * z[e]; }
        sy = wave_sum(sy); sz = wave_sum(sz);
        const float ry = __builtin_amdgcn_rsqf(sy * (1.0f / 512.0f) + EPS), rz = __builtin_amdgcn_rsqf(sz * (1.0f / 512.0f) + EPS);
        u32x4 wy, wz;
        wy.x = pk_bf16(y[0] * ry * gr0[0], y[1] * ry * gr0[1]); wy.y = pk_bf16(y[2] * ry * gr0[2], y[3] * ry * gr0[3]); wy.z = pk_bf16(y[4] * ry * gr1[0], y[5] * ry * gr1[1]); wy.w = pk_bf16(y[6] * ry * gr1[2], y[7] * ry * gr1[3]);
        wz.x = pk_bf16(z[0] * rz * ga0[0], z[1] * rz * ga0[1]); wz.y = pk_bf16(z[2] * rz * ga0[2], z[3] * rz * ga0[3]); wz.z = pk_bf16(z[4] * rz * ga1[0], z[5] * rz * ga1[1]); wz.w = pk_bf16(z[6] * rz * ga1[2], z[7] * rz * ga1[3]);
        *(u32x4*)(Y + row * DM + 8 * lane) = wy; *(u32x4*)(Y + row * DM + 512 + 8 * lane) = wz;
    }
    __syncthreads();
}

__device__ __forceinline__ int panel_scales(const pg8::StaticOrder& S, const float* ssq, float* rsl, int tid) {
    pg8::Unit u0; int pm = -1;
    if (S.next(0, u0)) { pm = u0.pm;
        if (tid < 256) { const f32x4* p = (const f32x4*)(ssq + ((size_t)pm * 256 + tid) * 16); const f32x4 a = p[0], b = p[1], c = p[2], d = p[3];
            const float s = ((a[0] + a[1]) + (a[2] + a[3])) + ((b[0] + b[1]) + (b[2] + b[3])) + ((c[0] + c[1]) + (c[2] + c[3])) + ((d[0] + d[1]) + (d[2] + d[3]));
            rsl[tid] = __builtin_amdgcn_rsqf(s * (1.0f / 1024.0f) + 1e-6f); } }
    __syncthreads();
    return pm;
}

__global__ void __launch_bounds__(NTHR, 2) fwd_megakernel(Args a) {
    extern __shared__ __attribute__((aligned(16))) unsigned char lds[];
    cg::grid_group grid = cg::this_grid();
    const int tid = threadIdx.x, lane = tid & 63, wave = __builtin_amdgcn_readfirstlane(tid >> 6);
    const int G = gridDim.x, bx = blockIdx.x;
    const int gw = bx * NWAVES + wave, NGW = G * NWAVES;
    unsigned char* ws = a.ws;
    PG8_LAS unsigned char* glds = (PG8_LAS unsigned char*)lds;
    const int lo = a.ph_lo, hi = a.ph_hi;
    if (tid < 64) ((LAS unsigned*)(glds + LDS_CTL_OFF))[tid] = 0u;
    __syncthreads();
    XcdBarrier bar; bar.bar = (unsigned*)(ws + WS_BAR); bar.x = 0; bar.st = nullptr;
    if (hi - lo > 1) bar = xcd_barrier_post((unsigned*)(ws + WS_BAR), (volatile LAS unsigned*)(glds + LDS_CTL_OFF));
#define IN(k) (lo <= (k) && (k) < hi)
    if (a.ph_hi > N_PHASES) grid.sync();
#define SEAM(k) do { if (IN(k) && IN((k) + 1)) xcd_barrier(bar); } while (0)
    bf16_t* XB = (bf16_t*)(ws + WS_XB); float* SSQ0 = (float*)(ws + WS_SSQ); float* SSQ1 = SSQ0 + (size_t)T * 16; float* SSQ2 = SSQ1 + (size_t)T * 16;
    bf16_t* ACT = (bf16_t*)(ws + WS_ACT);

    const bool split = (G == 256);
    if (IN(0)) { REP(0) phase_prologue(a, lds, gw, NGW, wave, lane, split); SEAM(0); }
    if (IN(1)) {
        pg8::Gemm g{XB, (const bf16_t*)(ws + WS_WGU1), T, 2 * DFF, DM}; pg8::StaticOrder S; S.init(T, 2 * DFF, G, bx);
        float* rsl = (float*)(lds + LDS_RS_OFF); const int pmc = panel_scales(S, SSQ0, rsl, tid);
        pg8::EpiSwiGLU E{ACT, DFF, SSQ0, rsl, pmc};
        REP(1) pg8::gemm_phase<pg8::EpiSwiGLU, pg8::StaticOrder, true, true>(glds, g, S, E);
        if (split && bx >= 128) convert_range(a, lds, CV_P0_END, CV_B_END - CV_F, (bx - 128) * NWAVES + wave, 128 * NWAVES, wave, lane);
        SEAM(1); }
    if (IN(2)) {
        pg8::Gemm g{ACT, (const bf16_t*)(ws + WS_WD1), T, DM, DFF}; pg8::StaticOrder S; S.init(T, DM, G, bx);
        pg8::EpiResid E{XB, nullptr, XB, SSQ1, 0.5f};
        REP(2) pg8::gemm_phase<pg8::EpiResid, pg8::StaticOrder, true, true>(glds, g, S, E); SEAM(2); }
    if (IN(3)) {
        pg8::Gemm g{XB, (const bf16_t*)(ws + WS_WIN), T, NIN, DM}; pg8::StaticOrder S; S.init(T, NIN, G, bx);
        float* rsl = (float*)(lds + LDS_RS_OFF); const int pmc = panel_scales(S, SSQ1, rsl, tid);
        pg8::EpiInProj E{(bf16_t*)(ws + WS_PROJ), SSQ1, a.in[I_QN], a.in[I_KN], rsl, pmc};
        REP(3) pg8::gemm_phase<pg8::EpiInProj, pg8::StaticOrder, true, true>(glds, g, S, E);
        if (split && bx >= 128) convert_range(a, lds, CV_B_END - CV_F, CV_END, (bx - 128) * NWAVES + wave, 128 * NWAVES, wave, lane);
        SEAM(3); }
    if (IN(4)) {
        { const int gc = 32 * (bx & 7) + (bx >> 3), b = gc >> 6, c = gc & 63, hw = bx * 4 + (wave & 3), NHW = G * 4, w2 = wave - 4;
          if (wave < 4) { const int id0 = split ? ((b << 9) | (wave << 6) | c) : hw, idstep = split ? 256 : NHW, idend = split ? id0 + 512 : 2048;
              __builtin_amdgcn_s_setprio(2); REP(4) for (int it = id0; it < idend; it += idstep) rnn_item(a, it, lds + wave * 16384, lane); __builtin_amdgcn_s_setprio(0); }
          else { const int first = split ? ((b << 10) | ((4 * (w2 & 1)) << 7) | (2 * c + (w2 >> 1))) : hw;
              REP(41) attn_wave(a, first, split ? 128 : NHW, split ? first + 512 : 4096, lds + wave * 16384, lane); } }
        if (!split) SEAM(4); }
    if (IN(5)) { if (split && IN(4)) { asm volatile("s_waitcnt vmcnt(0)" ::: "memory"); __syncthreads(); }
                 REP(5) for (int u = split ? 32 * (bx & 7) + (bx >> 3) : bx; u < 4 * NCHUNK; u += split ? 4 * NCHUNK : G) finalize_unit(a, u, (float*)lds, tid, wave, lane); SEAM(5); }
    if (IN(6)) {
        pg8::Gemm g{(const bf16_t*)(ws + WS_Y), (const bf16_t*)(ws + WS_WOUT), T, DM, DM}; pg8::StaticOrder S; S.init(T, DM, G, bx);
        pg8::EpiResid E{XB, nullptr, XB, SSQ2, 1.0f};
        pg8::gemm_phase<pg8::EpiResid, pg8::StaticOrder, true, true>(glds, g, S, E); SEAM(6); }
    if (IN(7)) {
        pg8::Gemm g{XB, (const bf16_t*)(ws + WS_WGU2), T, 2 * DFF, DM}; pg8::StaticOrder S; S.init(T, 2 * DFF, G, bx);
        float* rsl = (float*)(lds + LDS_RS_OFF); const int pmc = panel_scales(S, SSQ2, rsl, tid);
        pg8::EpiSwiGLU E{ACT, DFF, SSQ2, rsl, pmc};
        pg8::gemm_phase<pg8::EpiSwiGLU, pg8::StaticOrder, true, true>(glds, g, S, E); SEAM(7); }
    if (IN(8)) {
        pg8::Gemm g{ACT, (const bf16_t*)(ws + WS_WD2), T, DM, DFF}; pg8::StaticOrder S; S.init(T, DM, G, bx);
        pg8::EpiResid E{XB, a.out, nullptr, nullptr, 0.5f};
        pg8::gemm_phase<pg8::EpiResid, pg8::StaticOrder, true, true>(glds, g, S, E); }
#undef IN
#undef SEAM
}

extern "C" void kernel_launch(void* const* d_in, const int* in_sizes, int n_in, void* d_out, int out_size, void* d_ws, size_t ws_size, hipStream_t stream) {
    static int grid = 0;
    if (grid == 0) {
        if (n_in != 23 || in_sizes[0] != T * DM || out_size != T * DM || ws_size < WS_END2) { fprintf(stderr, "kernel_launch: unexpected shapes (n_in %d, in0 %d, out %d, ws %zu)\n", n_in, n_in > 0 ? in_sizes[0] : -1, out_size, ws_size); grid = -1; return; }
        int dev = 0, cus = 0, per_cu = 0;
        hipGetDevice(&dev); hipDeviceGetAttribute(&cus, hipDeviceAttributeMultiprocessorCount, dev);
        if (hipFuncSetAttribute((const void*)fwd_megakernel, hipFuncAttributeMaxDynamicSharedMemorySize, LDS_BYTES) != hipSuccess) { fprintf(stderr, "kernel_launch: hipFuncSetAttribute failed\n"); grid = -1; return; }
        if (hipOccupancyMaxActiveBlocksPerMultiprocessor(&per_cu, (const void*)fwd_megakernel, NTHR, LDS_BYTES) != hipSuccess || per_cu < 1) { fprintf(stderr, "kernel_launch: occupancy query says %d\n", per_cu); per_cu = 1; }
        (void)hipGetLastError();
        grid = cus * 1;
        if (grid <= 0) grid = 256;
    }
    if (grid < 0) return;
    Args a{};
    for (int i = 0; i < 23; ++i) a.in[i] = (const float*)d_in[i];
    a.out = (float*)d_out; a.ws = (unsigned char*)d_ws;
#if MK_LAUNCHES == 1
    if (hipMemsetAsync((char*)d_ws + WS_BAR, 0, BAR_ZERO_BYTES, stream) != hipSuccess) { fprintf(stderr, "kernel_launch: memset failed\n"); return; }
    a.ph_lo = 0; a.ph_hi = N_PHASES;
    void* args[] = {&a};
    hipError_t e = hipLaunchCooperativeKernel((const void*)fwd_megakernel, dim3(grid), dim3(NTHR), args, LDS_BYTES, stream);
    if (e != hipSuccess) fprintf(stderr, "kernel_launch: cooperative launch failed: %s (grid %d)\n", hipGetErrorString(e), grid);
#else
    for (int p = 0; p < N_PHASES; ++p) { a.ph_lo = p; a.ph_hi = p + 1; hipLaunchKernelGGL(fwd_megakernel, dim3(grid), dim3(NTHR), LDS_BYTES, stream, a); }
#endif
}
```

```cpp
#include <hip/hip_runtime.h>
#include <cstdio>
#include <cstdint>
namespace pg8 {
#define PG8_LAS __attribute__((address_space(3)))
typedef unsigned short bf16_t;
typedef short bf16x8 __attribute__((ext_vector_type(8)));
typedef float f32x4 __attribute__((ext_vector_type(4)));
typedef unsigned u32x4 __attribute__((ext_vector_type(4)));
constexpr int BM = 256, BK = 64, HALF = 128, HTB = HALF * BK * 2  , STAGE_BYTES = 8 * HTB, NXCD = 8, WGM = 8;

__host__ __device__ __forceinline__ int lds_byte(int r, int c) { const int st = (r >> 4) * 2 + (c >> 5), rr = r & 15, cc = c & 31, ob = rr * 64 + cc * 2; return st * 1024 + (ob ^ (((ob >> 9) & 1) << 5)); }
__host__ __device__ __forceinline__ void stage_rc(int b, int& R, int& C) { const int st = b / 1024, sb = b % 1024, swz = sb ^ (((sb >> 9) & 1) << 5); R = (st >> 1) * 16 + swz / 64; C = (st & 1) * 32 + (swz % 64) / 2; }
__host__ __device__ __forceinline__ int perm32(int rho) { const int n = rho >> 4, i = rho & 15; return 8 * (i >> 2) + 4 * n + (i & 3); }

struct Unit { int pm, pn; };
struct Gemm { const bf16_t* A; const bf16_t* Bt; int M, N, K; };

struct StaticOrder {
    int nM, nN, nwg, G, c;
    __host__ __device__ void init(int M, int N, int G_, int c_) { nM = M / BM; nN = N / BM; nwg = nM * nN; G = G_; c = c_; }
    __host__ __device__ bool next(int i, Unit& u) const {
        const long L = (long)i * G + c; if (L >= nwg) return false;
        int wgid = (int)L; { const int q = nwg / NXCD, r = nwg % NXCD, xcd = wgid % NXCD, off = wgid / NXCD; wgid = (xcd < r ? xcd * (q + 1) : r * (q + 1) + (xcd - r) * q) + off; }
        const int nig = WGM * nN, gid = wgid / nig, fm = gid * WGM, gsz = (nM - fm) < WGM ? (nM - fm) : WGM;
        u.pm = fm + ((wgid % nig) % gsz); u.pn = (wgid % nig) / gsz; return true;
    }
    __device__ __forceinline__ void a_ready(const Unit&) const {}
    __device__ __forceinline__ void done(const Unit&) const {}
};

__device__ __forceinline__ unsigned cvt_pk_bf16(float lo, float hi) { unsigned r; asm volatile("v_cvt_pk_bf16_f32 %0, %1, %2" : "=v"(r) : "v"(lo), "v"(hi)); return r; }
typedef float f32x2 __attribute__((ext_vector_type(2)));

__device__ __forceinline__ float row_rs(const float* ssq, int row, int fq, float inv_n, float eps) {
    const f32x4 a = *(const f32x4*)(ssq + (size_t)row * 16 + 4 * fq);
    float s = (a[0] + a[1]) + (a[2] + a[3]);
    s += __shfl_xor(s, 16); s += __shfl_xor(s, 32);
    return __builtin_amdgcn_rsqf(s * inv_n + eps);
}
__device__ __forceinline__ float silu_mul(float g, float up) { return g * __builtin_amdgcn_rcpf(1.0f + __builtin_amdgcn_exp2f(-1.4426950408889634f * g)) * up; }

struct EpiSwiGLU {
    static constexpr bool PERM = true, AFTER_DRAIN = false;
    bf16_t* O; int ldc; const float* ssq; const float* rsl; int pm_c;
    __device__ __forceinline__ void operator()(const f32x4 (&acc)[2][2][4][2], const Unit& u, int wr, int wc, int fr, int fq) const {
        const int row0 = u.pm * BM + wr * 64 + fr, col0 = u.pn * HALF + wc * 32 + 8 * fq;
        float rsv[2][4];
        if (u.pm == pm_c) {
#pragma unroll
            for (int ai = 0; ai < 2; ++ai)
#pragma unroll
                for (int m = 0; m < 4; ++m) rsv[ai][m] = rsl[ai * HALF + wr * 64 + m * 16 + fr];
        } else {
            asm volatile("" ::: "memory");
#pragma unroll
            for (int ai = 0; ai < 2; ++ai)
#pragma unroll
                for (int m = 0; m < 4; ++m) rsv[ai][m] = row_rs(ssq, row0 + ai * HALF + m * 16, fq, 1.0f / 1024.0f, 1e-6f);
        }
#pragma unroll
        for (int ai = 0; ai < 2; ++ai)
#pragma unroll
            for (int m = 0; m < 4; ++m) {
                const int row = row0 + ai * HALF + m * 16;
                const float rs = rsv[ai][m];
                float o[8];
#pragma unroll
                for (int n = 0; n < 2; ++n)
#pragma unroll
                    for (int e = 0; e < 4; ++e) o[n * 4 + e] = silu_mul(acc[ai][0][m][n][e] * rs, acc[ai][1][m][n][e] * rs);
                u32x4 w; w.x = cvt_pk_bf16(o[0], o[1]); w.y = cvt_pk_bf16(o[2], o[3]); w.z = cvt_pk_bf16(o[4], o[5]); w.w = cvt_pk_bf16(o[6], o[7]);
                *(u32x4*)(O + (size_t)row * ldc + col0) = w;
            }
    }
};

struct EpiResid {
    static constexpr bool PERM = true, AFTER_DRAIN = false;
    const bf16_t* rb; float* outf; bf16_t* xb; float* ssq_out; float alpha;
    __device__ __forceinline__ void operator()(const f32x4 (&acc)[2][2][4][2], const Unit& u, int wr, int wc, int fr, int fq) const {
        const int row0 = u.pm * BM + wr * 64 + fr, col0 = u.pn * BM + wc * 32 + 8 * fq;
        u32x4 rv[2][4][2];
#pragma unroll
        for (int ai = 0; ai < 2; ++ai)
#pragma unroll
            for (int m = 0; m < 4; ++m)
#pragma unroll
                for (int bj = 0; bj < 2; ++bj) rv[ai][m][bj] = *(const u32x4*)(rb + (size_t)(row0 + ai * HALF + m * 16) * 1024 + col0 + bj * HALF);
#pragma unroll
        for (int ai = 0; ai < 2; ++ai)
#pragma unroll
            for (int m = 0; m < 4; ++m) {
                const int row = row0 + ai * HALF + m * 16; float s = 0.f;
#pragma unroll
                for (int bj = 0; bj < 2; ++bj) {
                    const size_t off = (size_t)row * 1024 + col0 + bj * HALF; const u32x4 r = rv[ai][m][bj];
                    const f32x4 r0 = {__uint_as_float(r.x << 16), __uint_as_float(r.x & 0xffff0000u), __uint_as_float(r.y << 16), __uint_as_float(r.y & 0xffff0000u)};
                    const f32x4 r1 = {__uint_as_float(r.z << 16), __uint_as_float(r.z & 0xffff0000u), __uint_as_float(r.w << 16), __uint_as_float(r.w & 0xffff0000u)};
                    const f32x4 v0 = r0 + acc[ai][bj][m][0] * alpha, v1 = r1 + acc[ai][bj][m][1] * alpha;
                    if (outf) { __builtin_nontemporal_store(v0, (f32x4*)(outf + off)); __builtin_nontemporal_store(v1, (f32x4*)(outf + off + 4)); }
                    if (xb) { u32x4 w; w.x = cvt_pk_bf16(v0[0], v0[1]); w.y = cvt_pk_bf16(v0[2], v0[3]); w.z = cvt_pk_bf16(v1[0], v1[1]); w.w = cvt_pk_bf16(v1[2], v1[3]); *(u32x4*)(xb + off) = w; }
                    s += ((v0[0] * v0[0] + v0[1] * v0[1]) + (v0[2] * v0[2] + v0[3] * v0[3])) + ((v1[0] * v1[0] + v1[1] * v1[1]) + (v1[2] * v1[2] + v1[3] * v1[3]));
                }
                if (ssq_out) { s += __shfl_xor(s, 16); s += __shfl_xor(s, 32); if (fq == 0) ssq_out[(size_t)row * 16 + u.pn * 4 + wc] = s; }
            }
    }
};

struct EpiInProj {
    static constexpr bool PERM = true, AFTER_DRAIN = false;
    bf16_t* O; const float* ssq; const float* qn; const float* kn; const float* rsl; int pm_c;
    __device__ __forceinline__ void operator()(const f32x4 (&acc)[2][2][4][2], const Unit& u, int wr, int wc, int fr, int fq) const {
        const int row0 = u.pm * BM + wr * 64 + fr, col0 = u.pn * BM + wc * 64 + 8 * fq;
        const bool isq = (u.pn == 4 || u.pn == 5), isk = (u.pn == 6 || u.pn == 7), hn = isq || isk;
        f32x4 gn[2][2];
#pragma unroll
        for (int bj = 0; bj < 2; ++bj)
#pragma unroll
            for (int n = 0; n < 2; ++n) { gn[bj][n] = (f32x4){1.f, 1.f, 1.f, 1.f}; if (hn) gn[bj][n] = *(const f32x4*)((isq ? qn : kn) + 32 * bj + 8 * fq + 4 * n) * (isq ? 0.125f : 1.0f); }
        float rsv[2][4];
        if (u.pm == pm_c) {
#pragma unroll
            for (int ai = 0; ai < 2; ++ai)
#pragma unroll
                for (int m = 0; m < 4; ++m) rsv[ai][m] = rsl[ai * HALF + wr * 64 + m * 16 + fr];
        } else {
            asm volatile("" ::: "memory");
#pragma unroll
            for (int ai = 0; ai < 2; ++ai)
#pragma unroll
                for (int m = 0; m < 4; ++m) rsv[ai][m] = row_rs(ssq, row0 + ai * HALF + m * 16, fq, 1.0f / 1024.0f, 1e-6f);
        }
#pragma unroll
        for (int ai = 0; ai < 2; ++ai)
#pragma unroll
            for (int m = 0; m < 4; ++m) {
                const int row = row0 + ai * HALF + m * 16;
                const float rs = rsv[ai][m];
                f32x4 v[2][2]; float s = 0.f;
#pragma unroll
                for (int bj = 0; bj < 2; ++bj)
#pragma unroll
                    for (int n = 0; n < 2; ++n) { v[bj][n] = acc[ai][bj][m][n] * rs; const f32x4 t = v[bj][n]; s += (t[0] * t[0] + t[1] * t[1]) + (t[2] * t[2] + t[3] * t[3]); }
                if (hn) { s += __shfl_xor(s, 16); s += __shfl_xor(s, 32); const float rq = __builtin_amdgcn_rsqf(s * (1.0f / 64.0f) + 1e-6f);
#pragma unroll
                    for (int bj = 0; bj < 2; ++bj)
#pragma unroll
                        for (int n = 0; n < 2; ++n) v[bj][n] = v[bj][n] * rq * gn[bj][n]; }
#pragma unroll
                for (int bj = 0; bj < 2; ++bj) { u32x4 w; w.x = cvt_pk_bf16(v[bj][0][0], v[bj][0][1]); w.y = cvt_pk_bf16(v[bj][0][2], v[bj][0][3]); w.z = cvt_pk_bf16(v[bj][1][0], v[bj][1][1]); w.w = cvt_pk_bf16(v[bj][1][2], v[bj][1][3]);
                    *(u32x4*)(O + (size_t)row * 2560 + col0 + 32 * bj) = w; }
            }
    }
};

template <class Epi, class Sched, bool ALIGN_EPI = false, bool SP2 = false>
__device__ __forceinline__ void gemm_phase(PG8_LAS unsigned char* lds, const Gemm g, const Sched& S, const Epi& E) {
    const int tid = threadIdx.x, wid = __builtin_amdgcn_readfirstlane(tid >> 6), lane = tid & 63, wr = wid >> 2, wc = wid & 3, fr = lane & 15, fq = lane >> 4;
    const int K = g.K, nt = K / BK;
    unsigned voffA[2], voffB[2];
#pragma unroll
    for (int i = 0; i < 2; ++i) { int R, C; stage_rc(tid * 16 + i * 8192, R, C); const int Rb = Epi::PERM ? ((R & ~31) + perm32(R & 31)) : R;
        voffA[i] = (unsigned)(R * K + C) * 2u; voffB[i] = (unsigned)(Rb * K + C) * 2u; }
    const size_t kstep = (size_t)(BK * 2);
    const size_t hstep = (size_t)HALF * K * 2;
    const size_t tstep = 2 * hstep;
    const unsigned ldsw = (unsigned)wid * 1024u;
    const int aoff = lds_byte(wr * 64 + fr, fq * 8), boff = lds_byte(wc * 32 + fr, fq * 8);
#define PG8_SA(b, h) (((b) * 2 + (h)) * HTB)
#define PG8_SB(b, h) ((4 + (b) * 2 + (h)) * HTB)
#define PG8_STAGE(bufoff, gbase, voff) do { _Pragma("unroll") for (int _i = 0; _i < 2; ++_i) \
        __builtin_amdgcn_global_load_lds((const unsigned*)((const char*)(gbase) + (voff)[_i]), (PG8_LAS unsigned*)(lds + (bufoff) + ldsw + _i * 8192), 16, 0, 0); } while (0)
#define PG8_LDA(dst, b, h) do { _Pragma("unroll") for (int m = 0; m < 4; ++m) _Pragma("unroll") for (int k = 0; k < 2; ++k) dst[m][k] = *(const PG8_LAS bf16x8*)(lds + PG8_SA(b, h) + aoff + m * 2048 + k * 1024); } while (0)
#define PG8_LDB(dst, b, h) do { _Pragma("unroll") for (int n = 0; n < 2; ++n) _Pragma("unroll") for (int k = 0; k < 2; ++k) dst[n][k] = *(const PG8_LAS bf16x8*)(lds + PG8_SB(b, h) + boff + n * 2048 + k * 1024); } while (0)
#define PG8_MMA(ai, bj, At, Bt) do { __builtin_amdgcn_s_setprio(1); _Pragma("unroll") for (int m = 0; m < 4; ++m) _Pragma("unroll") for (int n = 0; n < 2; ++n) _Pragma("unroll") for (int k = 0; k < 2; ++k) \
        acc[ai][bj][m][n] = __builtin_amdgcn_mfma_f32_16x16x32_bf16(Bt[n][k], At[m][k], acc[ai][bj][m][n], 0, 0, 0); __builtin_amdgcn_s_setprio(0); } while (0)
#define PG8_WAIT_V(n) asm volatile("s_waitcnt vmcnt(" #n ")" ::: "memory")
#define PG8_WAIT_L(n) asm volatile("s_waitcnt lgkmcnt(" #n ")" ::: "memory")
#define PG8_BAR __builtin_amdgcn_s_barrier()
#define PG8_SCHED __builtin_amdgcn_sched_barrier(0)
    Unit cur, nxt; int ui = 0;
    if (!S.next(0, cur)) return;
    f32x4 acc[2][2][4][2];
#pragma unroll
    for (int a = 0; a < 2; ++a)
#pragma unroll
        for (int b = 0; b < 2; ++b)
#pragma unroll
            for (int m = 0; m < 4; ++m)
#pragma unroll
                for (int n = 0; n < 2; ++n) acc[a][b][m][n] = (f32x4){0.f, 0.f, 0.f, 0.f};
    bf16x8 At[4][2], B0[2][2], B1[2][2];
    const char* cA = (const char*)g.A + (size_t)cur.pm * tstep; const char* cB = (const char*)g.Bt + (size_t)cur.pn * tstep;
    S.a_ready(cur);
    if constexpr (SP2) {
        PG8_STAGE(PG8_SB(0, 0), cB, voffB); PG8_STAGE(PG8_SB(0, 1), cB + hstep, voffB); PG8_STAGE(PG8_SA(0, 0), cA, voffA); PG8_STAGE(PG8_SA(0, 1), cA + hstep, voffA);
        if (wr == 1) PG8_BAR;
        PG8_WAIT_V(2); PG8_BAR;
        PG8_STAGE(PG8_SB(1, 0), cB + kstep, voffB); PG8_STAGE(PG8_SA(1, 0), cA + kstep, voffA); PG8_STAGE(PG8_SB(1, 1), cB + hstep + kstep, voffB);
        PG8_WAIT_V(6); PG8_BAR;
    } else {
        PG8_STAGE(PG8_SB(0, 0), cB, voffB); PG8_STAGE(PG8_SA(0, 0), cA, voffA); PG8_STAGE(PG8_SB(0, 1), cB + hstep, voffB); PG8_STAGE(PG8_SA(0, 1), cA + hstep, voffA);
        if (wr == 1) PG8_BAR;
        PG8_WAIT_V(4); PG8_BAR;
        PG8_STAGE(PG8_SB(1, 0), cB + kstep, voffB); PG8_STAGE(PG8_SA(1, 0), cA + kstep, voffA); PG8_STAGE(PG8_SB(1, 1), cB + hstep + kstep, voffB);
        PG8_WAIT_V(6); PG8_BAR;
    }
    for (;;) {
        const bool has_next = S.next(ui + 1, nxt);
        const char* nA = has_next ? (const char*)g.A + (size_t)nxt.pm * tstep : cA; const char* nB = has_next ? (const char*)g.Bt + (size_t)nxt.pn * tstep : cB;
        for (int t = 0; t < nt; t += 2) {
            const bool last = (t == nt - 2);
            const char* a1 = cA + (size_t)(t + 1) * kstep;
            const char* a2 = last ? nA : cA + (size_t)(t + 2) * kstep; const char* b2 = last ? nB : cB + (size_t)(t + 2) * kstep;
            const char* a3 = a2 + kstep; const char* b3 = b2 + kstep;
            if (last && has_next) S.a_ready(nxt);
            if constexpr (SP2) {
            PG8_LDB(B0, 0, 0); PG8_LDB(B1, 0, 1); PG8_SCHED; PG8_LDA(At, 0, 0); PG8_STAGE(PG8_SA(1, 1), a1 + hstep, voffA);
            PG8_WAIT_V(8); PG8_WAIT_L(0); PG8_BAR; PG8_MMA(0, 0, At, B0); PG8_MMA(0, 1, At, B1); PG8_BAR; PG8_SCHED;
            PG8_LDA(At, 0, 1); PG8_STAGE(PG8_SB(0, 0), b2, voffB); PG8_STAGE(PG8_SB(0, 1), b2 + hstep, voffB); PG8_STAGE(PG8_SA(0, 0), a2, voffA);
            PG8_WAIT_V(8); PG8_WAIT_L(0); PG8_BAR; PG8_MMA(1, 0, At, B0); PG8_MMA(1, 1, At, B1); PG8_BAR; PG8_SCHED;
            PG8_LDB(B0, 1, 0); PG8_LDB(B1, 1, 1); PG8_SCHED; PG8_LDA(At, 1, 0); PG8_STAGE(PG8_SA(0, 1), a2 + hstep, voffA);
            PG8_WAIT_V(8); PG8_WAIT_L(0); PG8_BAR; PG8_MMA(0, 0, At, B0); PG8_MMA(0, 1, At, B1); PG8_BAR; PG8_SCHED;
            PG8_LDA(At, 1, 1); PG8_STAGE(PG8_SB(1, 0), b3, voffB); PG8_STAGE(PG8_SB(1, 1), b3 + hstep, voffB); PG8_STAGE(PG8_SA(1, 0), a3, voffA);
            PG8_WAIT_V(8); PG8_WAIT_L(0); PG8_BAR; PG8_MMA(1, 0, At, B0); PG8_MMA(1, 1, At, B1); PG8_BAR; PG8_SCHED;
            } else {
            PG8_LDB(B0, 0, 0); PG8_SCHED; PG8_LDA(At, 0, 0); PG8_STAGE(PG8_SA(1, 1), a1 + hstep, voffA);
            PG8_WAIT_L(8); PG8_BAR; PG8_WAIT_L(0); PG8_MMA(0, 0, At, B0); PG8_BAR; PG8_SCHED;
            PG8_LDB(B1, 0, 1); PG8_STAGE(PG8_SB(0, 0), b2, voffB);
            PG8_BAR; PG8_WAIT_L(0); PG8_MMA(0, 1, At, B1); PG8_BAR;
            PG8_LDA(At, 0, 1); PG8_STAGE(PG8_SA(0, 0), a2, voffA);
            PG8_BAR; PG8_WAIT_L(0); PG8_MMA(1, 0, At, B0); PG8_BAR; PG8_SCHED;
            PG8_STAGE(PG8_SB(0, 1), b2 + hstep, voffB);
            PG8_WAIT_V(6); PG8_BAR; PG8_MMA(1, 1, At, B1); PG8_BAR;
            PG8_LDB(B0, 1, 0); PG8_SCHED; PG8_LDA(At, 1, 0); PG8_STAGE(PG8_SA(0, 1), a2 + hstep, voffA);
            PG8_WAIT_L(8); PG8_BAR; PG8_WAIT_L(0); PG8_MMA(0, 0, At, B0); PG8_BAR; PG8_SCHED;
            PG8_LDB(B1, 1, 1); PG8_STAGE(PG8_SB(1, 0), b3, voffB);
            PG8_BAR; PG8_WAIT_L(0); PG8_MMA(0, 1, At, B1); PG8_BAR;
            PG8_LDA(At, 1, 1); PG8_STAGE(PG8_SA(1, 0), a3, voffA);
            PG8_BAR; PG8_WAIT_L(0); PG8_MMA(1, 0, At, B0); PG8_BAR; PG8_SCHED;
            PG8_STAGE(PG8_SB(1, 1), b3 + hstep, voffB);
            PG8_WAIT_V(6); PG8_BAR; PG8_MMA(1, 1, At, B1); PG8_BAR;
            }
        }
        if constexpr (ALIGN_EPI) { if (wr == 0) PG8_BAR; }
        if constexpr (!Epi::AFTER_DRAIN) { E(acc, cur, wr, wc, fr, fq); S.done(cur); }
        if (!has_next) break;
#pragma unroll
        for (int a = 0; a < 2; ++a)
#pragma unroll
            for (int b = 0; b < 2; ++b)
#pragma unroll
                for (int m = 0; m < 4; ++m)
#pragma unroll
                    for (int n = 0; n < 2; ++n) acc[a][b][m][n] = (f32x4){0.f, 0.f, 0.f, 0.f};
        cur = nxt; cA = nA; cB = nB; ++ui;
        if constexpr (ALIGN_EPI) { if (wr == 1) PG8_BAR; }
    }
    PG8_WAIT_V(0);
    if constexpr (!ALIGN_EPI) { if (wr == 0) PG8_BAR; }
    PG8_BAR;
    if constexpr (Epi::AFTER_DRAIN) { E.fused(acc, cur, wr, wc, fr, fq, lds, wid, lane); S.done(cur); }
#undef PG8_SA
#undef PG8_SB
#undef PG8_STAGE
#undef PG8_LDA
#undef PG8_LDB
#undef PG8_MMA
#undef PG8_WAIT_V
#undef PG8_WAIT_L
#undef PG8_BAR
#undef PG8_SCHED
}
}

#include <hip/hip_cooperative_groups.h>
namespace cg = cooperative_groups;
#ifndef DOUBLE_PHASE
#define DOUBLE_PHASE (-1)
#endif
#define REP(k) for (int rep_ = 0; rep_ < ((DOUBLE_PHASE) == (k) ? 2 : 1); ++rep_)
#ifndef MK_LAUNCHES
#define MK_LAUNCHES 1
#endif
typedef unsigned short bf16_t;
typedef float f32x4 __attribute__((ext_vector_type(4)));
typedef unsigned u32x4 __attribute__((ext_vector_type(4)));
typedef unsigned u32x2 __attribute__((ext_vector_type(2)));
constexpr int NWAVES = 8, NTHR = 512, N_PHASES = 9;
constexpr int T = 16384, SEQ = 4096, DM = 1024, DFF = 2816, NIN = 2560, DRNN = 512, NCHUNK = 64;
constexpr float EPS = 1e-6f;
constexpr size_t MiB = 1u << 20;
constexpr size_t WS_WIN = 0, WS_WOUT = 5 * MiB, WS_WGU2 = 7 * MiB, WS_WD2 = 18 * MiB, WS_SSQ = 24 * MiB, WS_SUM = 27 * MiB, WS_XB = 28 * MiB;
constexpr size_t WS_WGU1 = 60 * MiB, WS_WD1 = 71 * MiB, WS_ACT = 77 * MiB;
constexpr size_t WS_PROJ = 60 * MiB, WS_H = 140 * MiB, WS_P = 172 * MiB, WS_Y = 204 * MiB, WS_BAR = 236 * MiB, WS_END = 237 * MiB;
constexpr size_t WS_WPK = WS_BAR + 512 * 1024;
constexpr size_t WS_GRAN = 237 * MiB, WS_END2 = 239 * MiB;
constexpr size_t BAR_ZERO_BYTES = 16384;
static_assert(WS_WD2 + (size_t)DM * DFF * 2 <= WS_SSQ && WS_ACT + (size_t)T * DFF * 2 <= WS_Y && WS_PROJ + (size_t)T * NIN * 2 <= WS_H, "d_ws map");
constexpr int LDS_CTL_OFF = 131072, LDS_RS_OFF = 131072 + 256, LDS_BYTES = 131072 + 256 + 1024;

__device__ __forceinline__ float bf_lo(unsigned u) { return __uint_as_float(u << 16); }
__device__ __forceinline__ float bf_hi(unsigned u) { return __uint_as_float(u & 0xffff0000u); }
__device__ __forceinline__ float bf_1(bf16_t u) { return __uint_as_float((unsigned)u << 16); }
__device__ __forceinline__ unsigned pk_bf16(float lo, float hi) { return pg8::cvt_pk_bf16(lo, hi); }
__device__ __forceinline__ float wave_sum(float v) {
#pragma unroll
    for (int o = 1; o < 64; o <<= 1) v += __shfl_xor(v, o);
    return v;
}
__device__ __forceinline__ float gelu_tanh(float x) {
    const float x2 = x * x, t = __builtin_fmaf(x2, -2.0f * 1.4426950408889634f * 0.7978845608028654f * 0.044715f, -2.0f * 1.4426950408889634f * 0.7978845608028654f);
    return x * __builtin_amdgcn_rcpf(1.0f + __builtin_amdgcn_exp2f(x * t));
}

#define GAS __attribute__((address_space(1)))
#define LAS __attribute__((address_space(3)))
typedef GAS unsigned gu32;
typedef GAS unsigned long long gu64;
#define RLX_AGENT __ATOMIC_RELAXED, __HIP_MEMORY_SCOPE_AGENT
#define LDS_WAIT() asm volatile("s_waitcnt lgkmcnt(0)" ::: "memory")
#define VM_WAIT() asm volatile("s_waitcnt vmcnt(0)" ::: "memory")
__device__ __forceinline__ unsigned long long rt() { return __builtin_amdgcn_s_memrealtime(); }
#define XB_TMO      128
#define XB_XCNT(j)  (256  + 64 * (j))
#define XB_XSUB(j)  (1280 + 64 * (j))
#define XB_XGEN(j)  (2304 + 64 * (j))
#define XB_TOP      3328
#define XB_TOPGEN   3392
#define XCD_BAR_WORDS 3456
#define XB_SPIN_CAP (1u << 18)

__device__ __forceinline__ unsigned xb_ld(unsigned* p)              { return __hip_atomic_load(p, __ATOMIC_RELAXED, __HIP_MEMORY_SCOPE_AGENT); }
__device__ __forceinline__ unsigned xb_add(unsigned* p, unsigned v) { return __hip_atomic_fetch_add(p, v, __ATOMIC_RELAXED, __HIP_MEMORY_SCOPE_AGENT); }
__device__ __forceinline__ unsigned xb_xcc_id() { return (unsigned)__builtin_amdgcn_s_getreg((3 << 11) | 20) & 0xFu; }
#define XB_SPIN(cond, bar) do { unsigned _sp = 0; while (cond) { __builtin_amdgcn_s_sleep(1); \
    if ((++_sp & 255u) == 0u) { if (xb_ld(&(bar)[XB_TMO])) break; if (_sp > XB_SPIN_CAP) { atomicAdd(&(bar)[XB_TMO], 1u); break; } } } } while (0)

struct XcdBarrier {
    unsigned* bar; unsigned x;
    volatile LAS unsigned* st;
};

__device__ __forceinline__ XcdBarrier xcd_barrier_post(unsigned* bar, volatile LAS unsigned* st) {
    XcdBarrier b; b.bar = bar; b.x = xb_xcc_id(); b.st = st;
    if (threadIdx.x == 0) (void)xb_add(&bar[XB_XCNT(b.x)], 1u);
    return b;
}
__device__ __forceinline__ void xcd_barrier_complete(unsigned* bar, unsigned x, unsigned& nloc, unsigned& nx) {
    const unsigned G = gridDim.x * gridDim.y * gridDim.z;
    unsigned sum, cnt, mine, sp = 0u;
    for (;;) {
        sum = 0u; cnt = 0u; mine = 0u;
#pragma unroll
        for (unsigned j = 0; j < 16; ++j) { const unsigned c = xb_ld(&bar[XB_XCNT(j)]); sum += c; cnt += (c > 0u) ? 1u : 0u; mine = (j == x) ? c : mine; }
        if (sum == G) break;
        __builtin_amdgcn_s_sleep(1);
        if ((++sp & 255u) == 0u) { if (xb_ld(&bar[XB_TMO])) break; if (sp > XB_SPIN_CAP) { atomicAdd(&bar[XB_TMO], 1u); break; } }
    }
    nloc = mine > 0u ? mine : 1u; nx = cnt > 0u ? cnt : 1u;
}

__device__ __forceinline__ void xcd_barrier(const XcdBarrier& b) {
    asm volatile("s_waitcnt vmcnt(0)" ::: "memory");
    __syncthreads();
    if (threadIdx.x == 0) {
        unsigned* bar = b.bar;
        __builtin_amdgcn_s_waitcnt(0);
        unsigned nloc = b.st[0], nx = b.st[1];
        if (nloc == 0u) { xcd_barrier_complete(bar, b.x, nloc, nx); b.st[0] = nloc; b.st[1] = nx; }
        const unsigned old = xb_add(&bar[XB_XSUB(b.x)], 1u);
        const unsigned gen = old / nloc;
        if (old + 1u == (gen + 1u) * nloc) {
            __builtin_amdgcn_fence(__ATOMIC_RELEASE, "agent");
            asm volatile("s_waitcnt vmcnt(0)" ::: "memory");
            const unsigned og = xb_add(&bar[XB_TOP], 1u);
            const unsigned tg = og / nx;
            if (og + 1u == (tg + 1u) * nx) xb_add(&bar[XB_TOPGEN], 1u);
            else XB_SPIN(xb_ld(&bar[XB_TOPGEN]) == tg, bar);
            __builtin_amdgcn_fence(__ATOMIC_ACQUIRE, "agent");
            xb_add(&bar[XB_XGEN(b.x)], 1u);
            asm volatile("s_waitcnt vmcnt(0)" ::: "memory");
        } else {
            XB_SPIN(xb_ld(&bar[XB_XGEN(b.x)]) == gen, bar);
            __builtin_amdgcn_fence(__ATOMIC_ACQUIRE, "agent");
            asm volatile("s_waitcnt vmcnt(0)" ::: "memory");
        }
    }
    __syncthreads();
}


struct Args { const float* in[23]; float* out; unsigned char* ws; int ph_lo, ph_hi; };
enum { I_X = 0, I_N1, I_G1, I_U1, I_D1, I_MN, I_WIN, I_CW, I_CB, I_WA, I_BA, I_WX, I_BX, I_LAM, I_QN, I_KN, I_RON, I_AON, I_WOUT, I_N2, I_G2, I_U2, I_D2 };

__device__ __forceinline__ void transpose_item(const float* W, int K, int N, const float* gk, bf16_t* WT, int dst_row0, float* scr, int k0, int n0, int lane) {
    float wv[32];
#pragma unroll
    for (int i = 0; i < 32; ++i) wv[i] = __builtin_nontemporal_load(W + (size_t)(k0 + 2 * i + (lane >> 5)) * N + n0 + (lane & 31));
    if (gk) {
#pragma unroll
        for (int i = 0; i < 32; ++i) wv[i] *= gk[k0 + 2 * i + (lane >> 5)]; }
#pragma unroll
    for (int i = 0; i < 32; ++i) scr[(2 * i + (lane >> 5)) * 33 + (lane & 31)] = wv[i];
    asm volatile("s_waitcnt lgkmcnt(0)" ::: "memory");
    const int c = lane & 7;
#pragma unroll
    for (int j = 0; j < 4; ++j) { const int n = (lane >> 3) + 8 * j; const float* s = scr + (8 * c) * 33 + n;
        u32x4 o; o.x = pk_bf16(s[0 * 33], s[1 * 33]); o.y = pk_bf16(s[2 * 33], s[3 * 33]); o.z = pk_bf16(s[4 * 33], s[5 * 33]); o.w = pk_bf16(s[6 * 33], s[7 * 33]);
        *(u32x4*)(WT + (size_t)(dst_row0 + n) * K + k0 + 8 * c) = o; }
    asm volatile("s_waitcnt lgkmcnt(0)" ::: "memory");
}
constexpr int CV_F = (DM / 64) * (DFF / 32), CV_IN = (DM / 64) * (NIN / 32), CV_O = (DM / 64) * (DM / 32);
constexpr int CV_P0_END = 2 * CV_F, CV_A_END = 3 * CV_F, CV_B_END = CV_A_END + CV_IN + CV_O + CV_F, CV_END = CV_B_END + 2 * CV_F;
__device__ __forceinline__ void convert_item(const Args& a, float* scr, int id, int lane) {
    unsigned char* ws = a.ws; int r = id;
    if (r < 2 * CV_F || r >= CV_B_END) {
        const int ffn = r >= CV_B_END; if (ffn) r -= CV_B_END; const int up = r / CV_F; r -= up * CV_F;
        const float* W = a.in[ffn ? (up ? I_U2 : I_G2) : (up ? I_U1 : I_G1)]; const float* g = a.in[ffn ? I_N2 : I_N1];
        bf16_t* WT = (bf16_t*)(ws + (ffn ? WS_WGU2 : WS_WGU1));
        const int nblk = DFF / 32, kb = r / nblk, nb = r % nblk, n0 = 32 * nb;
        transpose_item(W, DM, DFF, g, WT, 256 * (n0 / 128) + 128 * up + (n0 % 128), scr, 64 * kb, n0, lane); return; }
    if (r < CV_A_END || r >= CV_A_END + CV_IN + CV_O) {
        const int ffn = r >= CV_A_END; r -= ffn ? (CV_A_END + CV_IN + CV_O) : 2 * CV_F;
        const int nblk = DM / 32, kb = r / nblk, nb = r % nblk, n0 = 32 * nb;
        transpose_item(a.in[ffn ? I_D2 : I_D1], DFF, DM, nullptr, (bf16_t*)(ws + (ffn ? WS_WD2 : WS_WD1)), n0, scr, 64 * kb, n0, lane); return; }
    r -= CV_A_END;
    if (r < CV_IN) {
        const int nblk = NIN / 32, kb = r / nblk, nb = r % nblk, n0 = 32 * nb, o = n0 % 256, wc = o / 64, bj = (o % 64) / 32;
        transpose_item(a.in[I_WIN], DM, NIN, a.in[I_MN], (bf16_t*)(ws + WS_WIN), (n0 - o) + 128 * bj + 32 * wc, scr, 64 * kb, n0, lane); return; }
    r -= CV_IN;
    { const int nblk = DM / 32, kb = r / nblk, nb = r % nblk, n0 = 32 * nb;
      transpose_item(a.in[I_WOUT], DM, DM, nullptr, (bf16_t*)(ws + WS_WOUT), n0, scr, 64 * kb, n0, lane); }
}
__device__ __forceinline__ void convert_range(const Args& a, unsigned char* lds, int first, int last, int w, int NW, int wave, int lane) {
    float* scr = (float*)(lds + wave * 16384);
    for (int id = first + w; id < last; id += NW) convert_item(a, scr, id, lane);
}
__device__ __forceinline__ void phase_prologue(const Args& a, unsigned char* lds, int gw, int NGW, int wave, int lane, bool split) {
    unsigned char* ws = a.ws;
    convert_range(a, lds, 0, split ? CV_P0_END : CV_END, gw, NGW, wave, lane);
    const float* x = a.in[I_X]; bf16_t* xb = (bf16_t*)(ws + WS_XB); float* ssq = (float*)(ws + WS_SSQ);
    const int rbase = split ? 2048 * ((gw >> 3) & 7) + 64 * (gw >> 6) + (gw & 7) : gw, rstep = split ? 8 : NGW, rend = split ? rbase + 64 : T;
    for (int m0 = rbase; m0 < rend; m0 += 8 * rstep) {
        f32x4 v[8][4]; float sq[8];
#pragma unroll
        for (int q = 0; q < 8; ++q) { const int m = (m0 + q * rstep < rend) ? m0 + q * rstep : m0; const f32x4* xr = (const f32x4*)(x + (size_t)m * DM) + lane;
#pragma unroll
            for (int j = 0; j < 4; ++j) v[q][j] = __builtin_nontemporal_load(xr + 64 * j); }
#pragma unroll
        for (int q = 0; q < 8; ++q) { float t = 0.f;
#pragma unroll
            for (int j = 0; j < 4; ++j) t += (v[q][j][0] * v[q][j][0] + v[q][j][1] * v[q][j][1]) + (v[q][j][2] * v[q][j][2] + v[q][j][3] * v[q][j][3]);
            sq[q] = wave_sum(t); }
#pragma unroll
        for (int q = 0; q < 8; ++q) { const int m = m0 + q * rstep; if (m < rend) { u32x2* o = (u32x2*)(xb + (size_t)m * DM) + lane;
#pragma unroll
            for (int j = 0; j < 4; ++j) { u32x2 w; w.x = pk_bf16(v[q][j][0], v[q][j][1]); w.y = pk_bf16(v[q][j][2], v[q][j][3]); o[64 * j] = w; }
            if (lane < 16) ssq[(size_t)m * 16 + lane] = (lane == 0) ? sq[q] : 0.f; } }
    }
    { unsigned long long* gr = (unsigned long long*)(ws + WS_GRAN); for (int i = gw * 64 + lane; i < 4 * NCHUNK * DRNN; i += NGW * 64) gr[i] = 0ull; }
    for (int idx = gw * 64 + lane; idx < 2 * 8 * 2 * 4 * 64; idx += NGW * 64) {
        const int l = idx & 63, ks = (idx >> 6) & 3, half = (idx >> 8) & 1, n = (idx >> 9) & 7, mat = idx >> 12;
        const float* w = a.in[mat ? I_WX : I_WA] + (size_t)(n * 64 + 16 * ks + 8 * (l >> 5)) * 64 + 32 * half + (l & 31);
        u32x4 pkd; pkd.x = pk_bf16(w[0], w[64]); pkd.y = pk_bf16(w[128], w[192]); pkd.z = pk_bf16(w[256], w[320]); pkd.w = pk_bf16(w[384], w[448]);
        ((u32x4*)(ws + WS_WPK))[idx] = pkd;
    }
}

typedef short bf16x8_t __attribute__((ext_vector_type(8)));
typedef float f32x16 __attribute__((ext_vector_type(16)));
__device__ __forceinline__ int crow(int r, int hi) { return (r & 3) + 8 * (r >> 2) + 4 * hi; }
__device__ __forceinline__ float sigmoid_fast(float x) { return __builtin_amdgcn_rcpf(1.0f + __builtin_amdgcn_exp2f(-1.4426950408889634f * x)); }
__device__ __forceinline__ void rnn_item(const Args& a, int item, unsigned char* wl, int lane) {
    constexpr int XP = 144;
    const int b = item >> 9, n = (item >> 6) & 7, c = item & 63, ql = lane & 31, hi = lane >> 5;
    unsigned char* ws = a.ws;
    const bf16_t* PROJ = (const bf16_t*)(ws + WS_PROJ); unsigned* HPg = (unsigned*)(ws + WS_H);
    const size_t row0 = (size_t)b * SEQ + (size_t)c * 64;
    u32x4 wfr[2][2][4];
#pragma unroll
    for (int mat = 0; mat < 2; ++mat)
#pragma unroll
        for (int hf = 0; hf < 2; ++hf)
#pragma unroll
            for (int ks = 0; ks < 4; ++ks) wfr[mat][hf][ks] = ((const u32x4*)(ws + WS_WPK))[(((mat * 8 + n) * 2 + hf) * 4 + ks) * 64 + lane];
    {
        const int ch = n * 64 + lane;
        const float cw0 = a.in[I_CW][ch], cw1 = a.in[I_CW][512 + ch], cw2 = a.in[I_CW][1024 + ch], cw3 = a.in[I_CW][1536 + ch], cb = a.in[I_CB][ch];
        const bf16_t* xp = PROJ + row0 * NIN + ch;
        float xm3 = 0.f, xm2 = 0.f, xm1 = 0.f;
        if (c > 0) { xm3 = bf_1(xp[-3 * NIN]); xm2 = bf_1(xp[-2 * NIN]); xm1 = bf_1(xp[-1 * NIN]); }
        bf16_t xv[64];
#pragma unroll
        for (int t = 0; t < 64; ++t) xv[t] = xp[(size_t)t * NIN];
#pragma unroll
        for (int t = 0; t < 64; ++t) { const float x0 = bf_1(xv[t]); const float xc = cb + cw0 * xm3 + cw1 * xm2 + cw2 * xm1 + cw3 * x0;
            ((bf16_t*)(wl + t * XP))[lane] = (bf16_t)(pk_bf16(xc, xc) & 0xffffu); xm3 = xm2; xm2 = xm1; xm1 = x0; }
    }
    asm volatile("s_waitcnt lgkmcnt(0)" ::: "memory");
#pragma unroll
    for (int dblk = 0; dblk < 2; ++dblk) {
        const int d = 32 * dblk + ql, ch = n * 64 + d;
        bf16x8_t bfa[4], bfx[4];
#pragma unroll
        for (int ks = 0; ks < 4; ++ks) { bfa[ks] = __builtin_bit_cast(bf16x8_t, wfr[0][dblk][ks]); bfx[ks] = __builtin_bit_cast(bf16x8_t, wfr[1][dblk][ks]); }
        const float ba = a.in[I_BA][ch], bx = a.in[I_BX][ch], lam = a.in[I_LAM][ch];
        const float lsl8l = -8.0f * 1.4426950408889634f * (fmaxf(-lam, 0.f) + log1pf(expf(-fabsf(lam))));
        const float ban = -1.4426950408889634f * ba, bxn = -1.4426950408889634f * bx;
        float cH = 0.f, cP = 1.f;
#pragma unroll
        for (int tb = 0; tb < 2; ++tb) {
            f32x16 R, I;
#pragma unroll
            for (int r = 0; r < 16; ++r) { R[r] = 0.f; I[r] = 0.f; }
#pragma unroll
            for (int ks = 0; ks < 4; ++ks) { const bf16x8_t af = *(const bf16x8_t*)(wl + (32 * tb + ql) * XP + (16 * ks + 8 * hi) * 2);
                R = __builtin_amdgcn_mfma_f32_32x32x16_bf16(af, bfa[ks], R, 0, 0, 0); I = __builtin_amdgcn_mfma_f32_32x32x16_bf16(af, bfx[ks], I, 0, 0, 0); }
            float xcl[16];
#pragma unroll
            for (int r = 0; r < 16; ++r) xcl[r] = bf_1(((const bf16_t*)(wl + (32 * tb + crow(r, hi)) * XP))[d]);
            float Hl[16], Pl[16], Ar[4], Br[4];
#pragma unroll
            for (int g = 0; g < 4; ++g) {
                float H = 0.f, P = 1.f;
#pragma unroll
                for (int e = 0; e < 4; ++e) {
                    const int r = 4 * g + e, t = 32 * tb + crow(r, hi);
                    const float rg = __builtin_amdgcn_rcpf(1.0f + __builtin_amdgcn_exp2f(__builtin_fmaf(R[r], -1.4426950408889634f, ban))), ig = __builtin_amdgcn_rcpf(1.0f + __builtin_amdgcn_exp2f(__builtin_fmaf(I[r], -1.4426950408889634f, bxn)));
                    const float av = __builtin_amdgcn_exp2f(rg * lsl8l);
                    const float m2 = (1.0f - av) * (1.0f + av);
                    const float xcv = xcl[r];
                    const float bv = __builtin_amdgcn_sqrtf(m2) * (ig * xcv);
                    H = av * H + bv; P *= av; Hl[r] = H; Pl[r] = P;
                }
                Ar[g] = P; Br[g] = H;
            }
            float myH[4], myP[4];
#pragma unroll
            for (int g = 0; g < 4; ++g) {
                const float pA = __shfl_xor(Ar[g], 32), pB = __shfl_xor(Br[g], 32);
                const float A0 = hi ? pA : Ar[g], B0 = hi ? pB : Br[g], A1 = hi ? Ar[g] : pA, B1 = hi ? Br[g] : pB;
                const float eH = cH, eP = cP;
                cH = A0 * cH + B0; cP = A0 * cP;
                myH[g] = hi ? cH : eH; myP[g] = hi ? cP : eP;
                cH = A1 * cH + B1; cP = A1 * cP;
            }
#pragma unroll
            for (int r = 0; r < 16; ++r) {
                const unsigned o = ((unsigned)row0 + 32 * tb + crow(r, hi)) * DRNN + ch;
                HPg[o] = pk_bf16(Hl[r] + Pl[r] * myH[r >> 2], Pl[r] * myP[r >> 2]);
            }
        }
        if (hi == 0) {
            __hip_atomic_store((gu64*)(ws + WS_GRAN) + (size_t)(b * NCHUNK + c) * DRNN + ch, ((unsigned long long)__float_as_uint(cH) << 32) | (unsigned long long)(__float_as_uint(cP) | 1u), RLX_AGENT); }
    }
    asm volatile("s_waitcnt lgkmcnt(0)" ::: "memory");
}

typedef short s16x4_t __attribute__((ext_vector_type(4)));
typedef __attribute__((address_space(3))) s16x4_t* lds_s16x4_ptr;
constexpr int VPITCH = 192;
#define ATT_LOADK(KQ, tile) do { const int t_ = (tile) > 0 ? (tile) : 0; \
        _Pragma("unroll") for (int i = 0; i < 4; ++i) KQ[i] = *(const u32x4*)(kbase + (size_t)(t_ * 32 + (lane >> 3) + 8 * i) * NIN); } while (0)
#define ATT_LOADV(VV, tile) do { const int t_ = (tile) > 0 ? (tile) : 0; \
        _Pragma("unroll") for (int i = 0; i < 4; ++i) VV[i] = *(const u32x4*)(vbase + (size_t)(t_ * 32 + (lane >> 3) + 8 * i) * NIN); } while (0)
constexpr int KPITCH = 144, KLDS_OFF = 32 * VPITCH;
struct AttnPre { bf16x8_t qf[4]; u32x4 kq[4], kq1[4], vv[4], vn[4]; };
__device__ __forceinline__ void attn_fetch(const bf16_t* PROJ, int item, int lane, AttnPre& P) {
    const int b = item >> 10, h = (item >> 7) & 7, qt = item & 127, ql = lane & 31, hi = lane >> 5;
    const size_t rowb = (size_t)b * SEQ;
    const bf16_t* qrow = PROJ + (rowb + qt * 32 + ql) * NIN + 1024 + h * 64;
    const bf16_t* kbase = PROJ + rowb * NIN + 1536 + h * 64 + 8 * (lane & 7);
    const bf16_t* vbase = PROJ + rowb * NIN + 2048 + h * 64 + 8 * (lane & 7);
#pragma unroll
    for (int d0 = 0; d0 < 4; ++d0) P.qf[d0] = *(const bf16x8_t*)(qrow + 16 * d0 + 8 * hi);
    ATT_LOADK(P.kq, qt); ATT_LOADV(P.vv, qt); ATT_LOADK(P.kq1, qt - 1); ATT_LOADV(P.vn, qt - 1);
}
__device__ __forceinline__ void attn_wave(const Args& a, int first, int stride, int end, unsigned char* vlds, int lane) {
  if (first >= end) return;
  bf16_t* PROJ = (bf16_t*)(a.ws + WS_PROJ);
  AttnPre P; attn_fetch(PROJ, first, lane, P);
  for (int item = first;;) {
    const int b = item >> 10, h = (item >> 7) & 7, qt = item & 127;
    const size_t rowb = (size_t)b * SEQ; const int ql = lane & 31, hi = lane >> 5;
    bf16x8_t qf[4], kf[4]; u32x4 kq[4], vv[4], vn[4];
    unsigned char* kst = vlds + KLDS_OFF + (lane >> 3) * KPITCH + 16 * (lane & 7);
    const unsigned char* kfr = vlds + KLDS_OFF + ql * KPITCH + 16 * hi;
#pragma unroll
    for (int i = 0; i < 4; ++i) { qf[i] = P.qf[i]; vv[i] = P.vv[i]; vn[i] = P.vn[i]; *(u32x4*)(kst + 8 * i * KPITCH) = P.kq[i]; kq[i] = P.kq1[i]; }
#pragma unroll
    for (int d0 = 0; d0 < 4; ++d0) kf[d0] = *(const bf16x8_t*)(kfr + 32 * d0);
    f32x16 o0, o1;
#pragma unroll
    for (int r = 0; r < 16; ++r) { o0[r] = 0.f; o1[r] = 0.f; }
    float C = 0.f;
    const bf16_t* kbase = PROJ + rowb * NIN + 1536 + h * 64 + 8 * (lane & 7);
    const bf16_t* vbase = PROJ + rowb * NIN + 2048 + h * 64 + 8 * (lane & 7);
    unsigned char* vst = vlds + (lane >> 3) * VPITCH + 16 * (lane & 7);
    const lds_s16x4_ptr vtr0 = (lds_s16x4_ptr)(__attribute__((address_space(3))) unsigned char*)(vlds + (4 * hi + ((lane & 15) >> 2)) * VPITCH + (16 * ((lane >> 4) & 1) + 4 * (lane & 3)) * 2);
    for (int kt = qt; kt >= 0; --kt) {
        f32x16 p;
#pragma unroll
        for (int r = 0; r < 16; ++r) p[r] = 0.f;
#pragma unroll
        for (int d0 = 0; d0 < 4; ++d0) p = __builtin_amdgcn_mfma_f32_32x32x16_bf16(kf[d0], qf[d0], p, 0, 0, 0);
#pragma unroll
        for (int i = 0; i < 4; ++i) { *(u32x4*)(vst + 8 * i * VPITCH) = vv[i]; *(u32x4*)(kst + 8 * i * KPITCH) = kq[i]; vv[i] = vn[i]; }
        ATT_LOADK(kq, kt - 2); ATT_LOADV(vn, kt - 2);
        const bool diag = (kt == qt);
        float be[16], om[16];
#pragma unroll
        for (int r = 0; r < 16; ++r) {
            const float z = p[r];
            const float e = __builtin_amdgcn_exp2f(-1.4426950408889634f * __builtin_fabsf(z)), rc = __builtin_amdgcn_rcpf(1.0f + e), er = e * rc;
            const bool pos = z >= 0.f;
            be[r] = pos ? rc : er; om[r] = pos ? er : rc;
        }
        if (diag) {
#pragma unroll
            for (int r = 0; r < 16; ++r) { const bool act = crow(r, hi) < ql; be[r] = act ? be[r] : 0.f; om[r] = act ? om[r] : 1.0f; }
        }
        float s2[4], s1[4], s0[4], t[4], u[4];
#pragma unroll
        for (int g = 0; g < 4; ++g) { s2[g] = om[4 * g + 3]; s1[g] = s2[g] * om[4 * g + 2]; s0[g] = s1[g] * om[4 * g + 1]; const float G = s0[g] * om[4 * g]; t[g] = __shfl_xor(G, 32); u[g] = G * t[g]; }
        float U[4]; U[3] = 1.0f; U[2] = u[3]; U[1] = u[3] * u[2]; U[0] = U[1] * u[1];
        const float total = U[0] * u[0];
        const float eC = __builtin_amdgcn_exp2f(1.4426950408889634f * C);
        float w[16];
#pragma unroll
        for (int g = 0; g < 4; ++g) {
            const float base = eC * U[g] * (hi == 0 ? t[g] : 1.0f);
            w[4 * g + 3] = be[4 * g + 3] * base; w[4 * g + 2] = be[4 * g + 2] * (s2[g] * base); w[4 * g + 1] = be[4 * g + 1] * (s1[g] * base); w[4 * g] = be[4 * g] * (s0[g] * base);
        }
        C += 0.6931471805599453f * __builtin_amdgcn_logf(total);
        u32x4 wp0, wp1;
        wp0.x = pk_bf16(w[0], w[1]); wp0.y = pk_bf16(w[2], w[3]); wp0.z = pk_bf16(w[4], w[5]); wp0.w = pk_bf16(w[6], w[7]);
        wp1.x = pk_bf16(w[8], w[9]); wp1.y = pk_bf16(w[10], w[11]); wp1.z = pk_bf16(w[12], w[13]); wp1.w = pk_bf16(w[14], w[15]);
        const bf16x8_t wf0 = __builtin_bit_cast(bf16x8_t, wp0), wf1 = __builtin_bit_cast(bf16x8_t, wp1);
        asm volatile("s_waitcnt lgkmcnt(0)" ::: "memory");
#pragma unroll
        for (int dblk = 0; dblk < 2; ++dblk)
#pragma unroll
            for (int ks = 0; ks < 2; ++ks) {
                const s16x4_t lo = __builtin_bit_cast(s16x4_t, __builtin_amdgcn_ds_read_tr16_b64_v4i16((lds_s16x4_ptr)((__attribute__((address_space(3))) unsigned char*)vtr0 + (16 * ks) * VPITCH + 64 * dblk)));
                const s16x4_t hh = __builtin_bit_cast(s16x4_t, __builtin_amdgcn_ds_read_tr16_b64_v4i16((lds_s16x4_ptr)((__attribute__((address_space(3))) unsigned char*)vtr0 + (16 * ks + 8) * VPITCH + 64 * dblk)));
                const bf16x8_t vf = (bf16x8_t){lo[0], lo[1], lo[2], lo[3], hh[0], hh[1], hh[2], hh[3]};
                if (dblk == 0) o0 = __builtin_amdgcn_mfma_f32_32x32x16_bf16(vf, ks ? wf1 : wf0, o0, 0, 0, 0);
                else           o1 = __builtin_amdgcn_mfma_f32_32x32x16_bf16(vf, ks ? wf1 : wf0, o1, 0, 0, 0);
            }
        asm volatile("s_waitcnt lgkmcnt(0)" ::: "memory");
#pragma unroll
        for (int d0 = 0; d0 < 4; ++d0) kf[d0] = *(const bf16x8_t*)(kfr + 32 * d0);
        if (__all(C < -104.0f)) break;
    }
    const int nxt = item + stride; const bool more = nxt < end;
    if (more) attn_fetch(PROJ, nxt, lane, P);
    bf16_t* yrow = (bf16_t*)(a.ws + WS_Y) + (rowb + qt * 32 + ql) * DM + 512 + h * 64;
#pragma unroll
    for (int g = 0; g < 4; ++g) {
        u32x2 w0, w1; w0.x = pk_bf16(o0[4 * g], o0[4 * g + 1]); w0.y = pk_bf16(o0[4 * g + 2], o0[4 * g + 3]); w1.x = pk_bf16(o1[4 * g], o1[4 * g + 1]); w1.y = pk_bf16(o1[4 * g + 2], o1[4 * g + 3]);
        *(u32x2*)(yrow + 8 * g + 4 * hi) = w0; *(u32x2*)(yrow + 32 + 8 * g + 4 * hi) = w1;
    }
    if (!more) break;
    item = nxt;
  }
}

#undef ATT_LOADK
#undef ATT_LOADV
__device__ __forceinline__ void finalize_unit(const Args& a, int unit, float* carry, int tid, int wave, int lane) {
    const int b = unit >> 6, c = unit & 63;
    unsigned char* ws = a.ws;
    const bf16_t* PROJ = (const bf16_t*)(ws + WS_PROJ); const unsigned* HP = (const unsigned*)(ws + WS_H);
    bf16_t* Y = (bf16_t*)(ws + WS_Y);
    { float cr = 0.f;
      gu64* gp = (gu64*)(ws + WS_GRAN) + (size_t)(b * NCHUNK) * DRNN + tid;
      for (int c0 = 0; c0 < c; c0 += 32) {
          unsigned long long x[32];
          for (unsigned spins = 0;; ++spins) {
              bool ok = true;
#pragma unroll
              for (int k = 0; k < 32; ++k) { x[k] = ((c0 + k) < c) ? __hip_atomic_load(gp + (size_t)(c0 + k) * DRNN, RLX_AGENT) : 1ull; ok = ok && ((x[k] & 1ull) != 0ull); }
              if (ok || spins > (1u << 16)) break;
              __builtin_amdgcn_s_sleep(4);
          }
#pragma unroll
          for (int k = 0; k < 32; ++k) if ((c0 + k) < c) cr = __uint_as_float((unsigned)x[k]) * cr + __uint_as_float((unsigned)(x[k] >> 32));
      }
      carry[tid] = cr; }
    __syncthreads();
    const f32x4 c0 = *(const f32x4*)(carry + 8 * lane), c1 = *(const f32x4*)(carry + 8 * lane + 4);
    const f32x4 gr0 = *(const f32x4*)(a.in[I_RON] + 8 * lane), gr1 = *(const f32x4*)(a.in[I_RON] + 8 * lane + 4);
    const f32x4 ga0 = *(const f32x4*)(a.in[I_AON] + 8 * lane), ga1 = *(const f32x4*)(a.in[I_AON] + 8 * lane + 4);
#pragma unroll
    for (int i = 0; i < 8; ++i) {
        const size_t row = (size_t)b * SEQ + (size_t)c * 64 + wave * 8 + i;
        const u32x4 hp0 = __builtin_nontemporal_load((const u32x4*)(HP + row * DRNN + 8 * lane)), hp1 = __builtin_nontemporal_load((const u32x4*)(HP + row * DRNN + 8 * lane + 4));
        const u32x4 gt = __builtin_nontemporal_load((const u32x4*)(PROJ + row * NIN + 512 + 8 * lane));
        const u32x4 ya = __builtin_nontemporal_load((const u32x4*)(Y + row * DM + 512 + 8 * lane));
        float y[8], z[8];
        y[0] = (bf_lo(hp0.x) + bf_hi(hp0.x) * c0[0]) * gelu_tanh(bf_lo(gt.x)); y[1] = (bf_lo(hp0.y) + bf_hi(hp0.y) * c0[1]) * gelu_tanh(bf_hi(gt.x));
        y[2] = (bf_lo(hp0.z) + bf_hi(hp0.z) * c0[2]) * gelu_tanh(bf_lo(gt.y)); y[3] = (bf_lo(hp0.w) + bf_hi(hp0.w) * c0[3]) * gelu_tanh(bf_hi(gt.y));
        y[4] = (bf_lo(hp1.x) + bf_hi(hp1.x) * c1[0]) * gelu_tanh(bf_lo(gt.z)); y[5] = (bf_lo(hp1.y) + bf_hi(hp1.y) * c1[1]) * gelu_tanh(bf_hi(gt.z));
        y[6] = (bf_lo(hp1.z) + bf_hi(hp1.z) * c1[2]) * gelu_tanh(bf_lo(gt.w)); y[7] = (bf_lo(hp1.w) + bf_hi(hp1.w) * c1[3]) * gelu_tanh(bf_hi(gt.w));
        z[0] = bf_lo(ya.x); z[1] = bf_hi(ya.x); z[2] = bf_lo(ya.y); z[3] = bf_hi(ya.y); z[4] = bf_lo(ya.z); z[5] = bf_hi(ya.z); z[6] = bf_lo(ya.w); z[7] = bf_hi(ya.w);
        float sy = 0.f, sz = 0.f;
#pragma unroll
        for (int e = 0; e < 8; ++e) { sy += y[e] * y[e]; sz += z[e] * z[e]; }
        sy = wave_sum(sy); sz = wave_sum(sz);
        const float ry = __builtin_amdgcn_rsqf(sy * (1.0f / 512.0f) + EPS), rz = __builtin_amdgcn_rsqf(sz * (1.0f / 512.0f) + EPS);
        u32x4 wy, wz;
        wy.x = pk_bf16(y[0] * ry * gr0[0], y[1] * ry * gr0[1]); wy.y = pk_bf16(y[2] * ry * gr0[2], y[3] * ry * gr0[3]); wy.z = pk_bf16(y[4] * ry * gr1[0], y[5] * ry * gr1[1]); wy.w = pk_bf16(y[6] * ry * gr1[2], y[7] * ry * gr1[3]);
        wz.x = pk_bf16(z[0] * rz * ga0[0], z[1] * rz * ga0[1]); wz.y = pk_bf16(z[2] * rz * ga0[2], z[3] * rz * ga0[3]); wz.z = pk_bf16(z[4] * rz * ga1[0], z[5] * rz * ga1[1]); wz.w = pk_bf16(z[6] * rz * ga1[2], z[7] * rz * ga1[3]);
        *(u32x4*)(Y + row * DM + 8 * lane) = wy; *(u32x4*)(Y + row * DM + 512 + 8 * lane) = wz;
    }
    __syncthreads();
}

__device__ __forceinline__ int panel_scales(const pg8::StaticOrder& S, const float* ssq, float* rsl, int tid) {
    pg8::Unit u0; int pm = -1;
    if (S.next(0, u0)) { pm = u0.pm;
        if (tid < 256) { const f32x4* p = (const f32x4*)(ssq + ((size_t)pm * 256 + tid) * 16); const f32x4 a = p[0], b = p[1], c = p[2], d = p[3];
            const float s = ((a[0] + a[1]) + (a[2] + a[3])) + ((b[0] + b[1]) + (b[2] + b[3])) + ((c[0] + c[1]) + (c[2] + c[3])) + ((d[0] + d[1]) + (d[2] + d[3]));
            rsl[tid] = __builtin_amdgcn_rsqf(s * (1.0f / 1024.0f) + 1e-6f); } }
    __syncthreads();
    return pm;
}

__global__ void __launch_bounds__(NTHR, 2) fwd_megakernel(Args a) {
    extern __shared__ __attribute__((aligned(16))) unsigned char lds[];
    cg::grid_group grid = cg::this_grid();
    const int tid = threadIdx.x, lane = tid & 63, wave = __builtin_amdgcn_readfirstlane(tid >> 6);
    const int G = gridDim.x, bx = blockIdx.x;
    const int gw = bx * NWAVES + wave, NGW = G * NWAVES;
    unsigned char* ws = a.ws;
    PG8_LAS unsigned char* glds = (PG8_LAS unsigned char*)lds;
    const int lo = a.ph_lo, hi = a.ph_hi;
    if (tid < 64) ((LAS unsigned*)(glds + LDS_CTL_OFF))[tid] = 0u;
    __syncthreads();
    XcdBarrier bar; bar.bar = (unsigned*)(ws + WS_BAR); bar.x = 0; bar.st = nullptr;
    if (hi - lo > 1) bar = xcd_barrier_post((unsigned*)(ws + WS_BAR), (volatile LAS unsigned*)(glds + LDS_CTL_OFF));
#define IN(k) (lo <= (k) && (k) < hi)
    if (a.ph_hi > N_PHASES) grid.sync();
#define SEAM(k) do { if (IN(k) && IN((k) + 1)) xcd_barrier(bar); } while (0)
    bf16_t* XB = (bf16_t*)(ws + WS_XB); float* SSQ0 = (float*)(ws + WS_SSQ); float* SSQ1 = SSQ0 + (size_t)T * 16; float* SSQ2 = SSQ1 + (size_t)T * 16;
    bf16_t* ACT = (bf16_t*)(ws + WS_ACT);

    const bool split = (G == 256);
    if (IN(0)) { REP(0) phase_prologue(a, lds, gw, NGW, wave, lane, split); SEAM(0); }
    if (IN(1)) {
        pg8::Gemm g{XB, (const bf16_t*)(ws + WS_WGU1), T, 2 * DFF, DM}; pg8::StaticOrder S; S.init(T, 2 * DFF, G, bx);
        float* rsl = (float*)(lds + LDS_RS_OFF); const int pmc = panel_scales(S, SSQ0, rsl, tid);
        pg8::EpiSwiGLU E{ACT, DFF, SSQ0, rsl, pmc};
        REP(1) pg8::gemm_phase<pg8::EpiSwiGLU, pg8::StaticOrder, true, true>(glds, g, S, E);
        if (split && bx >= 128) convert_range(a, lds, CV_P0_END, CV_B_END - CV_F, (bx - 128) * NWAVES + wave, 128 * NWAVES, wave, lane);
        SEAM(1); }
    if (IN(2)) {
        pg8::Gemm g{ACT, (const bf16_t*)(ws + WS_WD1), T, DM, DFF}; pg8::StaticOrder S; S.init(T, DM, G, bx);
        pg8::EpiResid E{XB, nullptr, XB, SSQ1, 0.5f};
        REP(2) pg8::gemm_phase<pg8::EpiResid, pg8::StaticOrder, true, true>(glds, g, S, E); SEAM(2); }
    if (IN(3)) {
        pg8::Gemm g{XB, (const bf16_t*)(ws + WS_WIN), T, NIN, DM}; pg8::StaticOrder S; S.init(T, NIN, G, bx);
        float* rsl = (float*)(lds + LDS_RS_OFF); const int pmc = panel_scales(S, SSQ1, rsl, tid);
        pg8::EpiInProj E{(bf16_t*)(ws + WS_PROJ), SSQ1, a.in[I_QN], a.in[I_KN], rsl, pmc};
        REP(3) pg8::gemm_phase<pg8::EpiInProj, pg8::StaticOrder, true, true>(glds, g, S, E);
        if (split && bx >= 128) convert_range(a, lds, CV_B_END - CV_F, CV_END, (bx - 128) * NWAVES + wave, 128 * NWAVES, wave, lane);
        SEAM(3); }
    if (IN(4)) {
        { const int gc = 32 * (bx & 7) + (bx >> 3), b = gc >> 6, c = gc & 63, hw = bx * 4 + (wave & 3), NHW = G * 4, w2 = wave - 4;
          if (wave < 4) { const int id0 = split ? ((b << 9) | (wave << 6) | c) : hw, idstep = split ? 256 : NHW, idend = split ? id0 + 512 : 2048;
              __builtin_amdgcn_s_setprio(2); REP(4) for (int it = id0; it < idend; it += idstep) rnn_item(a, it, lds + wave * 16384, lane); __builtin_amdgcn_s_setprio(0); }
          else { const int first = split ? ((b << 10) | ((4 * (w2 & 1)) << 7) | (2 * c + (w2 >> 1))) : hw;
              REP(41) attn_wave(a, first, split ? 128 : NHW, split ? first + 512 : 4096, lds + wave * 16384, lane); } }
        if (!split) SEAM(4); }
    if (IN(5)) { if (split && IN(4)) { asm volatile("s_waitcnt vmcnt(0)" ::: "memory"); __syncthreads(); }
                 REP(5) for (int u = split ? 32 * (bx & 7) + (bx >> 3) : bx; u < 4 * NCHUNK; u += split ? 4 * NCHUNK : G) finalize_unit(a, u, (float*)lds, tid, wave, lane); SEAM(5); }
    if (IN(6)) {
        pg8::Gemm g{(const bf16_t*)(ws + WS_Y), (const bf16_t*)(ws + WS_WOUT), T, DM, DM}; pg8::StaticOrder S; S.init(T, DM, G, bx);
        pg8::EpiResid E{XB, nullptr, XB, SSQ2, 1.0f};
        pg8::gemm_phase<pg8::EpiResid, pg8::StaticOrder, true, true>(glds, g, S, E); SEAM(6); }
    if (IN(7)) {
        pg8::Gemm g{XB, (const bf16_t*)(ws + WS_WGU2), T, 2 * DFF, DM}; pg8::StaticOrder S; S.init(T, 2 * DFF, G, bx);
        float* rsl = (float*)(lds + LDS_RS_OFF); const int pmc = panel_scales(S, SSQ2, rsl, tid);
        pg8::EpiSwiGLU E{ACT, DFF, SSQ2, rsl, pmc};
        pg8::gemm_phase<pg8::EpiSwiGLU, pg8::StaticOrder, true, true>(glds, g, S, E); SEAM(7); }
    if (IN(8)) {
        pg8::Gemm g{ACT, (const bf16_t*)(ws + WS_WD2), T, DM, DFF}; pg8::StaticOrder S; S.init(T, DM, G, bx);
        pg8::EpiResid E{XB, a.out, nullptr, nullptr, 0.5f};
        pg8::gemm_phase<pg8::EpiResid, pg8::StaticOrder, true, true>(glds, g, S, E); }
#undef IN
#undef SEAM
}

extern "C" void kernel_launch(void* const* d_in, const int* in_sizes, int n_in, void* d_out, int out_size, void* d_ws, size_t ws_size, hipStream_t stream) {
    static int grid = 0;
    if (grid == 0) {
        if (n_in != 23 || in_sizes[0] != T * DM || out_size != T * DM || ws_size < WS_END2) { fprintf(stderr, "kernel_launch: unexpected shapes (n_in %d, in0 %d, out %d, ws %zu)\n", n_in, n_in > 0 ? in_sizes[0] : -1, out_size, ws_size); grid = -1; return; }
        int dev = 0, cus = 0, per_cu = 0;
        hipGetDevice(&dev); hipDeviceGetAttribute(&cus, hipDeviceAttributeMultiprocessorCount, dev);
        if (hipFuncSetAttribute((const void*)fwd_megakernel, hipFuncAttributeMaxDynamicSharedMemorySize, LDS_BYTES) != hipSuccess) { fprintf(stderr, "kernel_launch: hipFuncSetAttribute failed\n"); grid = -1; return; }
        if (hipOccupancyMaxActiveBlocksPerMultiprocessor(&per_cu, (const void*)fwd_megakernel, NTHR, LDS_BYTES) != hipSuccess || per_cu < 1) { fprintf(stderr, "kernel_launch: occupancy query says %d\n", per_cu); per_cu = 1; }
        (void)hipGetLastError();
        grid = cus * 1;
        if (grid <= 0) grid = 256;
    }
    if (grid < 0) return;
    Args a{};
    for (int i = 0; i < 23; ++i) a.in[i] = (const float*)d_in[i];
    a.out = (float*)d_out; a.ws = (unsigned char*)d_ws;
#if MK_LAUNCHES == 1
    if (hipMemsetAsync((char*)d_ws + WS_BAR, 0, BAR_ZERO_BYTES, stream) != hipSuccess) { fprintf(stderr, "kernel_launch: memset failed\n"); return; }
    a.ph_lo = 0; a.ph_hi = N_PHASES;
    void* args[] = {&a};
    hipError_t e = hipLaunchCooperativeKernel((const void*)fwd_megakernel, dim3(grid), dim3(NTHR), args, LDS_BYTES, stream);
    if (e != hipSuccess) fprintf(stderr, "kernel_launch: cooperative launch failed: %s (grid %d)\n", hipGetErrorString(e), grid);
#else
    for (int p = 0; p < N_PHASES; ++p) { a.ph_lo = p; a.ph_hi = p + 1; hipLaunchKernelGGL(fwd_megakernel, dim3(grid), dim3(NTHR), LDS_BYTES, stream, a); }
#endif
}
```
